# Optimizing an MI355X kernel written in HIP

```python
import jax, jax.numpy as jnp
from jax import lax
import numpy as np

D_MODEL = 1024
BATCH = 8
SEQ = 4096
DEPTH = 1

HEAD_DIM = 128
N_ATTN_HEADS = D_MODEL // HEAD_DIM
D_ATTN = N_ATTN_HEADS * HEAD_DIM
D_LRU = D_MODEL
N_LRU_BLOCKS = 8
LRU_BLOCK = D_LRU // N_LRU_BLOCKS
CONV_WIDTH = 4
LRU_C = 8.0
D_MIX = D_ATTN + D_LRU
D_PLE = 256
Q_BLOCK = 128
RMS_EPS = 1e-6
D_IN = 4 * D_ATTN + N_ATTN_HEADS + 2 * D_LRU
SPLIT_POINTS = [D_ATTN, 2 * D_ATTN, 3 * D_ATTN, 3 * D_ATTN + N_ATTN_HEADS,
                4 * D_ATTN + N_ATTN_HEADS, 4 * D_ATTN + N_ATTN_HEADS + D_LRU]

kernel_name = "hymba_fox_rglru_sandwich_ple"


def rmsnorm(x, g):
    xf = x.astype(jnp.float32)
    y = xf * lax.rsqrt(jnp.mean(xf * xf, axis=-1, keepdims=True) + RMS_EPS) * g.astype(jnp.float32)
    return y.astype(x.dtype)


def forgetting_attention(q, k, v, f_logit):
    B, S, H, Dh = q.shape
    nblk = S // Q_BLOCK
    scale = HEAD_DIM ** -0.5
    q = q.transpose(0, 2, 1, 3)
    k = k.transpose(0, 2, 1, 3)
    v = v.transpose(0, 2, 1, 3)
    c = jnp.cumsum(jax.nn.log_sigmoid(f_logit.astype(jnp.float32)), axis=1).transpose(0, 2, 1)
    qb = q.reshape(B, H, nblk, Q_BLOCK, Dh).transpose(2, 0, 1, 3, 4)
    cb = c.reshape(B, H, nblk, Q_BLOCK).transpose(2, 0, 1, 3)
    kpos = jnp.arange(S)

    def one_block(args):
        qi, ci, bi = args
        qpos = bi * Q_BLOCK + jnp.arange(Q_BLOCK)
        s = jnp.einsum('bhqd,bhkd->bhqk', qi, k, preferred_element_type=jnp.float32) * scale
        s = s + (ci[:, :, :, None] - c[:, :, None, :])
        s = jnp.where(kpos[None, :] <= qpos[:, None], s, -jnp.inf)
        w = jax.nn.softmax(s, axis=-1)
        return jnp.einsum('bhqk,bhkd->bhqd', w.astype(v.dtype), v)

    ob = lax.map(one_block, (qb, cb, jnp.arange(nblk)))
    return ob.transpose(1, 0, 3, 2, 4).reshape(B, S, H * Dh)


def causal_depthwise_conv(x, w, b):
    y = lax.conv_general_dilated(
        x, w[:, None, :].astype(x.dtype), window_strides=(1,),
        padding=[(CONV_WIDTH - 1, 0)], dimension_numbers=('NWC', 'WIO', 'NWC'),
        feature_group_count=x.shape[-1])
    return y + b


def rg_lru(xc, w_r, b_r, w_i, b_i, lam):
    B, S, _ = xc.shape
    xb = xc.reshape(B, S, N_LRU_BLOCKS, LRU_BLOCK)
    r = jax.nn.sigmoid((jnp.einsum('bsnj,njk->bsnk', xb, w_r).reshape(B, S, D_LRU) + b_r).astype(jnp.float32))
    i = jax.nn.sigmoid((jnp.einsum('bsnj,njk->bsnk', xb, w_i).reshape(B, S, D_LRU) + b_i).astype(jnp.float32))
    log_a = -LRU_C * r * jax.nn.softplus(-lam.astype(jnp.float32))
    a = jnp.exp(log_a)
    u = jnp.sqrt(-jnp.expm1(2.0 * log_a)) * (i * xc.astype(jnp.float32))

    def combine(left, right):
        a_l, b_l = left
        a_r, b_r2 = right
        return a_l * a_r, a_r * b_l + b_r2

    _, h = lax.associative_scan(combine, (a, u), axis=1)
    return h.astype(xc.dtype)


def setup_inputs(seed: int = 0) -> dict:
    key = jax.random.key(seed)
    ks = jax.random.split(key, 24)
    f32 = jnp.float32
    nrm = lambda k, shape, s: jax.random.normal(k, shape, f32) * s
    x = jax.random.normal(ks[0], (BATCH, SEQ, D_MODEL), f32)
    p = jax.random.normal(ks[1], (DEPTH, BATCH, SEQ, D_PLE), f32)
    w_in = nrm(ks[2], (DEPTH, D_MODEL, D_IN), D_MODEL ** -0.5)
    b_f = jnp.linspace(1.0, 6.0, N_ATTN_HEADS, dtype=f32)[None, :] + nrm(ks[3], (DEPTH, N_ATTN_HEADS), 0.1)
    pre_gain = 1.0 + nrm(ks[4], (DEPTH, D_MODEL), 0.05)
    post_gain = 1.0 + nrm(ks[5], (DEPTH, D_MODEL), 0.05)
    conv_w = nrm(ks[6], (DEPTH, CONV_WIDTH, D_LRU), CONV_WIDTH ** -0.5)
    conv_b = nrm(ks[7], (DEPTH, D_LRU), 0.01)
    w_rgate = nrm(ks[8], (DEPTH, N_LRU_BLOCKS, LRU_BLOCK, LRU_BLOCK), LRU_BLOCK ** -0.5)
    b_rgate = nrm(ks[9], (DEPTH, D_LRU), 0.01)
    w_igate = nrm(ks[10], (DEPTH, N_LRU_BLOCKS, LRU_BLOCK, LRU_BLOCK), LRU_BLOCK ** -0.5)
    b_igate = nrm(ks[11], (DEPTH, D_LRU), 0.01)
    a_pow = jax.random.uniform(ks[12], (DEPTH, D_LRU), f32, minval=0.9, maxval=0.999)
    a0 = a_pow ** (1.0 / LRU_C)
    lru_lambda = jnp.log(a0) - jnp.log1p(-a0)
    attn_out_gain = 1.0 + nrm(ks[13], (DEPTH, D_ATTN), 0.05)
    lru_out_gain = 1.0 + nrm(ks[14], (DEPTH, D_LRU), 0.05)
    w_out = nrm(ks[15], (DEPTH, D_MIX, D_MODEL), D_MIX ** -0.5)
    w_ple = nrm(ks[16], (DEPTH, D_PLE, D_MODEL), D_PLE ** -0.5)
    ple_gain = 1.0 + nrm(ks[17], (DEPTH, D_MODEL), 0.05)
    w_ple_gate = nrm(ks[18], (DEPTH, D_MODEL, D_MODEL), D_MODEL ** -0.5)
    b_ple_gate = nrm(ks[19], (DEPTH, D_MODEL), 0.01)
    return {"x": x, "p": p, "w_in": w_in, "b_f": b_f, "pre_gain": pre_gain,
            "post_gain": post_gain, "conv_w": conv_w, "conv_b": conv_b,
            "w_rgate": w_rgate, "b_rgate": b_rgate, "w_igate": w_igate, "b_igate": b_igate,
            "lru_lambda": lru_lambda, "attn_out_gain": attn_out_gain, "lru_out_gain": lru_out_gain,
            "w_out": w_out, "w_ple": w_ple, "ple_gain": ple_gain,
            "w_ple_gate": w_ple_gate, "b_ple_gate": b_ple_gate}


def reference(x, p, w_in, b_f, pre_gain, post_gain, conv_w, conv_b, w_rgate, b_rgate,
              w_igate, b_igate, lru_lambda, attn_out_gain, lru_out_gain, w_out,
              w_ple, ple_gain, w_ple_gate, b_ple_gate):
    B, S, _ = x.shape
    h = x
    for i in range(DEPTH):
        xn = rmsnorm(h, pre_gain[i])
        z = xn @ w_in[i]
        q, k, v, fl, g_attn, x_lru, g_lru = jnp.split(z, SPLIT_POINTS, axis=-1)
        fl = fl + b_f[i]
        o_attn = forgetting_attention(q.reshape(B, S, N_ATTN_HEADS, HEAD_DIM),
                                      k.reshape(B, S, N_ATTN_HEADS, HEAD_DIM),
                                      v.reshape(B, S, N_ATTN_HEADS, HEAD_DIM), fl)
        y_attn = rmsnorm(o_attn, attn_out_gain[i]) * jax.nn.silu(g_attn)
        xc = causal_depthwise_conv(x_lru, conv_w[i], conv_b[i])
        o_lru = rg_lru(xc, w_rgate[i], b_rgate[i], w_igate[i], b_igate[i], lru_lambda[i])
        y_lru = rmsnorm(o_lru, lru_out_gain[i]) * jax.nn.silu(g_lru)
        mix = jnp.concatenate([y_attn, y_lru], axis=-1) @ w_out[i]
        h = h + rmsnorm(mix, post_gain[i])
        e = rmsnorm(p[i] @ w_ple[i], ple_gain[i])
        gate = jax.nn.sigmoid(h @ w_ple_gate[i] + b_ple_gate[i])
        h = h + gate * e
    return h
```

```cpp
#include <hip/hip_runtime.h>
#include <hip/hip_bf16.h>
#include <hip/hip_cooperative_groups.h>
#include <cstdio>
#include <cstdint>
namespace cg = cooperative_groups;

#ifndef N_LAUNCHES
#define N_LAUNCHES 1
#endif

namespace pg8 {
#define PG8_LAS __attribute__((address_space(3)))
typedef unsigned short bf16_t;
typedef short bf16x8 __attribute__((ext_vector_type(8)));
typedef float f32x4 __attribute__((ext_vector_type(4)));
typedef unsigned u32x4 __attribute__((ext_vector_type(4)));
constexpr int BM = 256, BK = 64, HALF = 128, HTB = HALF * BK * 2  , STAGE_BYTES = 8 * HTB, NXCD = 8, WGM = 8;

__host__ __device__ __forceinline__ int lds_byte(int r, int c) { const int st = (r >> 4) * 2 + (c >> 5), rr = r & 15, cc = c & 31, ob = rr * 64 + cc * 2; return st * 1024 + (ob ^ (((ob >> 9) & 1) << 5)); }
__host__ __device__ __forceinline__ void stage_rc(int b, int& R, int& C) { const int st = b / 1024, sb = b % 1024, swz = sb ^ (((sb >> 9) & 1) << 5); R = (st >> 1) * 16 + swz / 64; C = (st & 1) * 32 + (swz % 64) / 2; }
__host__ __device__ __forceinline__ int perm32(int rho) { const int n = rho >> 4, i = rho & 15; return 8 * (i >> 2) + 4 * n + (i & 3); }

struct Unit { int pm, pn, ui; };
struct Gemm { const bf16_t* A; const bf16_t* A2; const bf16_t* Bt; int M, N, K, lda, nt0; };

struct StaticOrder {
    int nM, nN, nwg, G, c;
    __host__ __device__ void init(int M, int N, int G_, int c_) { nM = M / BM; nN = N / BM; nwg = nM * nN; G = G_; c = c_; }
    __host__ __device__ bool next(int i, Unit& u) const {
        const long L = (long)i * G + c; if (L >= nwg) return false;
        int wgid = (int)L; { const int q = nwg / NXCD, r = nwg % NXCD, xcd = wgid % NXCD, off = wgid / NXCD; wgid = (xcd < r ? xcd * (q + 1) : r * (q + 1) + (xcd - r) * q) + off; }
        const int nig = WGM * nN, gid = wgid / nig, fm = gid * WGM, gsz = (nM - fm) < WGM ? (nM - fm) : WGM;
        u.pm = fm + ((wgid % nig) % gsz); u.pn = (wgid % nig) / gsz; u.ui = i; return true;
    }
    __device__ __forceinline__ void a_ready(const Unit&) const {}
    __device__ __forceinline__ void done(const Unit&) const {}
};
__device__ __forceinline__ unsigned cvt_pk_bf16(float lo, float hi) { unsigned r; asm volatile("v_cvt_pk_bf16_f32 %0, %1, %2" : "=v"(r) : "v"(lo), "v"(hi)); return r; }
typedef _Float16 h16x2_t __attribute__((ext_vector_type(2)));
__device__ __forceinline__ unsigned cvt_pk_f16(float lo, float hi) { const h16x2_t v = {(_Float16)lo, (_Float16)hi}; return __builtin_bit_cast(unsigned, v); }
__device__ __forceinline__ float h_lo(unsigned w) { return (float)__builtin_bit_cast(h16x2_t, w)[0]; }
__device__ __forceinline__ float h_hi(unsigned w) { return (float)__builtin_bit_cast(h16x2_t, w)[1]; }
__device__ __forceinline__ float sigm_f(float x) { return __builtin_amdgcn_rcpf(1.0f + __expf(-x)); }
__device__ __forceinline__ float silu_f(float x) { return x * sigm_f(x); }
__device__ __forceinline__ float bf_lo(unsigned w) { return __uint_as_float(w << 16); }
__device__ __forceinline__ float bf_hi(unsigned w) { return __uint_as_float(w & 0xffff0000u); }
constexpr float RMS_EPS = 1e-6f;
__device__ __forceinline__ float rstd_of(float ssq) { return 1.0f / sqrtf(ssq * (1.0f / 1024.0f) + RMS_EPS); }

struct EpiIn {
    static constexpr bool PERM = true, MID = false, AFTER_DRAIN = false, PREF = false;
    bf16_t* R0;
    __device__ __forceinline__ void mid(f32x4 (&)[2][2][4][2], const Unit&, int, int) const {}
    __device__ __forceinline__ void operator()(const f32x4 (&acc)[2][2][4][2], const Unit& u, int wr, int wc, int fr, int fq) const {
        const int region = u.pn >> 2, cr0 = (u.pn & 3) * 256 + wc * 32 + 8 * fq, row0 = u.pm * BM + wr * 64 + fr;
        if (region < 3) {
            bf16_t* base = R0 + (size_t)region * (32u << 20);
            const int b = row0 >> 12;
#pragma unroll
            for (int ai = 0; ai < 2; ++ai)
#pragma unroll
                for (int m = 0; m < 4; ++m) { const int s = (row0 + ai * HALF + m * 16) & 4095;
#pragma unroll
                    for (int bj = 0; bj < 2; ++bj) { const int c = cr0 + bj * HALF, head = c >> 7, d = c & 127;
                        const f32x4 v0 = acc[ai][bj][m][0], v1 = acc[ai][bj][m][1]; u32x4 w;
                        w.x = cvt_pk_bf16(v0[0], v0[1]); w.y = cvt_pk_bf16(v0[2], v0[3]); w.z = cvt_pk_bf16(v1[0], v1[1]); w.w = cvt_pk_bf16(v1[2], v1[3]);
                        *(u32x4*)(base + ((size_t)((b * 8 + head) * 4096 + s)) * 128 + d) = w; } }
        } else {
            bf16_t* base = R0 + (size_t)region * (32u << 20); const bool act = region != 4;
#pragma unroll
            for (int ai = 0; ai < 2; ++ai)
#pragma unroll
                for (int m = 0; m < 4; ++m) { bf16_t* rowp = base + (size_t)(row0 + ai * HALF + m * 16) * 1024 + cr0;
#pragma unroll
                    for (int bj = 0; bj < 2; ++bj) { f32x4 v0 = acc[ai][bj][m][0], v1 = acc[ai][bj][m][1];
                        if (act) { v0 = (f32x4){silu_f(v0[0]), silu_f(v0[1]), silu_f(v0[2]), silu_f(v0[3])}; v1 = (f32x4){silu_f(v1[0]), silu_f(v1[1]), silu_f(v1[2]), silu_f(v1[3])}; }
                        u32x4 w;
                        if (act) { w.x = cvt_pk_bf16(v0[0], v0[1]); w.y = cvt_pk_bf16(v0[2], v0[3]); w.z = cvt_pk_bf16(v1[0], v1[1]); w.w = cvt_pk_bf16(v1[2], v1[3]); }
                        else { w.x = cvt_pk_f16(v0[0], v0[1]); w.y = cvt_pk_f16(v0[2], v0[3]); w.z = cvt_pk_f16(v1[0], v1[1]); w.w = cvt_pk_f16(v1[2], v1[3]); }
                        *(u32x4*)(rowp + bj * HALF) = w; } }
        }
    }
};
struct EpiPle {
    static constexpr bool PERM = true, MID = false, AFTER_DRAIN = false, PREF = false;
    bf16_t* EP; float* ssq;
    __device__ __forceinline__ void mid(f32x4 (&)[2][2][4][2], const Unit&, int, int) const {}
    __device__ __forceinline__ void operator()(const f32x4 (&acc)[2][2][4][2], const Unit& u, int wr, int wc, int fr, int fq) const {
        const int col0 = u.pn * BM + wc * 32 + 8 * fq, row0 = u.pm * BM + wr * 64 + fr;
#pragma unroll
        for (int ai = 0; ai < 2; ++ai)
#pragma unroll
            for (int m = 0; m < 4; ++m) { const int r = row0 + ai * HALF + m * 16; float s2 = 0.f;
#pragma unroll
                for (int bj = 0; bj < 2; ++bj) { const f32x4 v0 = acc[ai][bj][m][0], v1 = acc[ai][bj][m][1];
                    s2 += (v0[0] * v0[0] + v0[1] * v0[1]) + (v0[2] * v0[2] + v0[3] * v0[3]) + (v1[0] * v1[0] + v1[1] * v1[1]) + (v1[2] * v1[2] + v1[3] * v1[3]);
                    u32x4 w; w.x = cvt_pk_bf16(v0[0], v0[1]); w.y = cvt_pk_bf16(v0[2], v0[3]); w.z = cvt_pk_bf16(v1[0], v1[1]); w.w = cvt_pk_bf16(v1[2], v1[3]);
                    *(u32x4*)(EP + (size_t)r * 1024 + col0 + bj * HALF) = w; }
                s2 += __shfl_xor(s2, 16); s2 += __shfl_xor(s2, 32);
                if (fq == 0) ssq[(size_t)(u.pn * 4 + wc) * 32768 + r] = s2; }
    }
};
struct EpiOut {
    static constexpr bool PERM = true, MID = true, AFTER_DRAIN = false, PREF = false;
    bf16_t* MIX; const PG8_LAS float* scm; const PG8_LAS float* sce; float* ssq_m;
    __device__ __forceinline__ void mid(f32x4 (&acc)[2][2][4][2], const Unit& u, int wr, int fr) const {
#pragma unroll
        for (int ai = 0; ai < 2; ++ai)
#pragma unroll
            for (int m = 0; m < 4; ++m) { const int r = u.pm * BM + ai * HALF + wr * 64 + m * 16 + fr;
                const float s = scm[u.ui * 256 + ai * HALF + wr * 64 + m * 16 + fr]; (void)r;
#pragma unroll
                for (int bj = 0; bj < 2; ++bj) { acc[ai][bj][m][0] *= s; acc[ai][bj][m][1] *= s; } }
    }
    __device__ __forceinline__ void operator()(const f32x4 (&acc)[2][2][4][2], const Unit& u, int wr, int wc, int fr, int fq) const {
        const int col0 = u.pn * BM + wc * 32 + 8 * fq, row0 = u.pm * BM + wr * 64 + fr;
        float rl8[2][4];
#pragma unroll
        for (int ai = 0; ai < 2; ++ai)
#pragma unroll
            for (int m = 0; m < 4; ++m) rl8[ai][m] = sce[u.ui * 256 + ai * HALF + wr * 64 + m * 16 + fr];
#pragma unroll
        for (int ai = 0; ai < 2; ++ai)
#pragma unroll
            for (int m = 0; m < 4; ++m) rl8[ai][m] = rl8[ai][m];
#pragma unroll
        for (int ai = 0; ai < 2; ++ai)
#pragma unroll
            for (int m = 0; m < 4; ++m) { const int r = row0 + ai * HALF + m * 16; float s2 = 0.f; const float rl = rl8[ai][m];
#pragma unroll
                for (int bj = 0; bj < 2; ++bj) { const f32x4 v0 = acc[ai][bj][m][0] * rl, v1 = acc[ai][bj][m][1] * rl;
                    s2 += (v0[0] * v0[0] + v0[1] * v0[1]) + (v0[2] * v0[2] + v0[3] * v0[3]) + (v1[0] * v1[0] + v1[1] * v1[1]) + (v1[2] * v1[2] + v1[3] * v1[3]);
                    u32x4 w; w.x = cvt_pk_bf16(v0[0], v0[1]); w.y = cvt_pk_bf16(v0[2], v0[3]); w.z = cvt_pk_bf16(v1[0], v1[1]); w.w = cvt_pk_bf16(v1[2], v1[3]);
                    *(u32x4*)(MIX + (size_t)r * 1024 + col0 + bj * HALF) = w; }
                s2 += __shfl_xor(s2, 16); s2 += __shfl_xor(s2, 32);
                if (fq == 0) ssq_m[(size_t)(u.pn * 4 + wc) * 32768 + r] = s2; }
    }
};
struct EpiFin {
    static constexpr bool PERM = true, MID = true, AFTER_DRAIN = false, PREF = false;
    __device__ __forceinline__ void pref(const Unit& u, int tid) const {
        const char* base = (const char*)(x + (size_t)(u.pm * BM) * 1024 + u.pn * BM);
        unsigned sink = 0u;
#pragma unroll
        for (int k = 0; k < 4; ++k) { const int line = tid + 512 * k; sink += *(const unsigned*)(base + (size_t)(line >> 3) * 4096 + (line & 7) * 128); }
        asm volatile("" :: "v"(sink));
    }
    const float* x; const PG8_LAS float* scm; const PG8_LAS float* sce; const PG8_LAS float* scr; const float* bg; const float* postg; const float* pleg;
    const bf16_t* MIX; const bf16_t* EP; float* out;
    __device__ __forceinline__ void mid(f32x4 (&acc)[2][2][4][2], const Unit& u, int wr, int fr) const {
#pragma unroll
        for (int ai = 0; ai < 2; ++ai)
#pragma unroll
            for (int m = 0; m < 4; ++m) { const int r = u.pm * BM + ai * HALF + wr * 64 + m * 16 + fr;
                const float s = scm[u.ui * 256 + ai * HALF + wr * 64 + m * 16 + fr]; (void)r;
#pragma unroll
                for (int bj = 0; bj < 2; ++bj) { acc[ai][bj][m][0] *= s; acc[ai][bj][m][1] *= s; } }
    }
    __device__ __forceinline__ void operator()(const f32x4 (&acc)[2][2][4][2], const Unit& u, int wr, int wc, int fr, int fq) const {
        const int col0 = u.pn * BM + wc * 32 + 8 * fq, row0 = u.pm * BM + wr * 64 + fr;
#pragma unroll
        for (int bj = 0; bj < 2; ++bj) { const int c = col0 + bj * HALF;
            const f32x4 b0 = *(const f32x4*)(bg + c), b1 = *(const f32x4*)(bg + c + 4), g0 = *(const f32x4*)(postg + c), g1 = *(const f32x4*)(postg + c + 4),
                        e0 = *(const f32x4*)(pleg + c), e1 = *(const f32x4*)(pleg + c + 4);
#pragma unroll
            for (int am = 0; am < 4; ++am) { const int ai = am >> 1, mb = (am & 1) * 2;
                f32x4 x0[2], x1[2]; u32x4 mw[2], ew[2];
#pragma unroll
                for (int k = 0; k < 2; ++k) { const int r = row0 + ai * HALF + (mb + k) * 16; const size_t off = (size_t)r * 1024 + c;
                    x0[k] = *(const f32x4*)(x + off); x1[k] = *(const f32x4*)(x + off + 4); mw[k] = *(const u32x4*)(MIX + off); ew[k] = *(const u32x4*)(EP + off); }
#pragma unroll
                for (int k = 0; k < 2; ++k) { const int m = mb + k; const int r = row0 + ai * HALF + m * 16; const size_t off = (size_t)r * 1024 + c;
                    const float rm = sce[u.ui * 256 + (r - u.pm * BM)], re = scr[u.ui * 256 + (r - u.pm * BM)];
                    const f32x4 a0 = acc[ai][bj][m][0] * rm + b0, a1 = acc[ai][bj][m][1] * rm + b1;
                    const f32x4 m0 = (f32x4){bf_lo(mw[k].x), bf_hi(mw[k].x), bf_lo(mw[k].y), bf_hi(mw[k].y)}, m1 = (f32x4){bf_lo(mw[k].z), bf_hi(mw[k].z), bf_lo(mw[k].w), bf_hi(mw[k].w)};
                    const f32x4 q0 = (f32x4){bf_lo(ew[k].x), bf_hi(ew[k].x), bf_lo(ew[k].y), bf_hi(ew[k].y)}, q1 = (f32x4){bf_lo(ew[k].z), bf_hi(ew[k].z), bf_lo(ew[k].w), bf_hi(ew[k].w)};
                    f32x4 o0, o1;
#pragma unroll
                    for (int j = 0; j < 4; ++j) { o0[j] = x0[k][j] + m0[j] * rm * g0[j] + sigm_f(a0[j]) * (q0[j] * re * e0[j]); o1[j] = x1[k][j] + m1[j] * rm * g1[j] + sigm_f(a1[j]) * (q1[j] * re * e1[j]); }
                    *(f32x4*)(out + off) = o0; *(f32x4*)(out + off + 4) = o1; } } }
    }
};
template <class Epi, class Sched, bool ALIGN_EPI = false, bool SP2 = false>
__device__ __forceinline__ void gemm_phase(PG8_LAS unsigned char* lds, const Gemm g, const Sched& S, const Epi& E) {
    int tid_ = threadIdx.x; asm volatile("" : "+v"(tid_));
    const int tid = tid_, wid = __builtin_amdgcn_readfirstlane(tid >> 6), lane = tid & 63, wr = wid >> 2, wc = wid & 3, fr = lane & 15, fq = lane >> 4;
    const int K = g.K, nt = K / BK;
    unsigned voffA[2], voffB[2];
#pragma unroll
    for (int i = 0; i < 2; ++i) { int R, C; stage_rc(tid * 16 + i * 8192, R, C); const int Rb = Epi::PERM ? ((R & ~31) + perm32(R & 31)) : R;
        voffA[i] = (unsigned)(R * g.lda + C) * 2u; voffB[i] = (unsigned)(Rb * K + C) * 2u; }
    const size_t kstep = (size_t)(BK * 2);
    const size_t hstep = (size_t)HALF * K * 2, tstep = 2 * hstep;
    const size_t hstepA = (size_t)HALF * g.lda * 2, tstepA = 2 * hstepA; const int nt0 = g.nt0;
#define PG8_APTR(c0, c1, tt) ((tt) < nt0 ? (c0) + (size_t)(tt) * kstep : (c1) + (size_t)((tt) - nt0) * kstep)
    const unsigned ldsw = (unsigned)wid * 1024u;
    const int aoff = lds_byte(wr * 64 + fr, fq * 8), boff = lds_byte(wc * 32 + fr, fq * 8);
#define PG8_SA(b, h) (((b) * 2 + (h)) * HTB)
#define PG8_SB(b, h) ((4 + (b) * 2 + (h)) * HTB)
#define PG8_STAGE(bufoff, gbase, voff) do { _Pragma("unroll") for (int _i = 0; _i < 2; ++_i) \
        __builtin_amdgcn_global_load_lds((const unsigned*)((const char*)(gbase) + (voff)[_i]), (PG8_LAS unsigned*)(lds + (bufoff) + ldsw + _i * 8192), 16, 0, 0); } while (0)
#define PG8_LDA(dst, b, h) do { _Pragma("unroll") for (int m = 0; m < 4; ++m) _Pragma("unroll") for (int k = 0; k < 2; ++k) dst[m][k] = *(const PG8_LAS bf16x8*)(lds + PG8_SA(b, h) + aoff + m * 2048 + k * 1024); } while (0)
#define PG8_LDB(dst, b, h) do { _Pragma("unroll") for (int n = 0; n < 2; ++n) _Pragma("unroll") for (int k = 0; k < 2; ++k) dst[n][k] = *(const PG8_LAS bf16x8*)(lds + PG8_SB(b, h) + boff + n * 2048 + k * 1024); } while (0)
#define PG8_MMA(ai, bj, At, Bt) do { __builtin_amdgcn_s_setprio(1); _Pragma("unroll") for (int m = 0; m < 4; ++m) _Pragma("unroll") for (int n = 0; n < 2; ++n) _Pragma("unroll") for (int k = 0; k < 2; ++k) \
        acc[ai][bj][m][n] = __builtin_amdgcn_mfma_f32_16x16x32_bf16(Bt[n][k], At[m][k], acc[ai][bj][m][n], 0, 0, 0); __builtin_amdgcn_s_setprio(0); } while (0)
#define PG8_WAIT_V(n) asm volatile("s_waitcnt vmcnt(" #n ")" ::: "memory")
#define PG8_WAIT_L(n) asm volatile("s_waitcnt lgkmcnt(" #n ")" ::: "memory")
#define PG8_BAR __builtin_amdgcn_s_barrier()
#define PG8_SCHED __builtin_amdgcn_sched_barrier(0)
    Unit cur, nxt; int ui = 0;
    if (!S.next(0, cur)) return;
    f32x4 acc[2][2][4][2];
#pragma unroll
    for (int a = 0; a < 2; ++a)
#pragma unroll
        for (int b = 0; b < 2; ++b)
#pragma unroll
            for (int m = 0; m < 4; ++m)
#pragma unroll
                for (int n = 0; n < 2; ++n) acc[a][b][m][n] = (f32x4){0.f, 0.f, 0.f, 0.f};
    bf16x8 At[4][2], B0[2][2], B1[2][2];
    const char* cA = (const char*)g.A + (size_t)cur.pm * tstepA; const char* cA2 = (const char*)g.A2 + (size_t)cur.pm * tstepA; const char* cB = (const char*)g.Bt + (size_t)cur.pn * tstep;
    S.a_ready(cur);
    if constexpr (SP2) {
        PG8_STAGE(PG8_SB(0, 0), cB, voffB); PG8_STAGE(PG8_SB(0, 1), cB + hstep, voffB); PG8_STAGE(PG8_SA(0, 0), cA, voffA); PG8_STAGE(PG8_SA(0, 1), cA + hstepA, voffA);
        if (wr == 1) PG8_BAR;
        PG8_WAIT_V(2); PG8_BAR;
        PG8_STAGE(PG8_SB(1, 0), cB + kstep, voffB); PG8_STAGE(PG8_SA(1, 0), cA + kstep, voffA); PG8_STAGE(PG8_SB(1, 1), cB + hstep + kstep, voffB);
        PG8_WAIT_V(6); PG8_BAR;
    } else {
        PG8_STAGE(PG8_SB(0, 0), cB, voffB); PG8_STAGE(PG8_SA(0, 0), cA, voffA); PG8_STAGE(PG8_SB(0, 1), cB + hstep, voffB); PG8_STAGE(PG8_SA(0, 1), cA + hstepA, voffA);
        if (wr == 1) PG8_BAR;
        PG8_WAIT_V(4); PG8_BAR;
        PG8_STAGE(PG8_SB(1, 0), cB + kstep, voffB); PG8_STAGE(PG8_SA(1, 0), cA + kstep, voffA); PG8_STAGE(PG8_SB(1, 1), cB + hstep + kstep, voffB);
        PG8_WAIT_V(6); PG8_BAR;
    }
    if constexpr (Epi::PREF) { int tp_ = threadIdx.x; asm volatile("" : "+v"(tp_)); E.pref(cur, tp_); }
    for (;;) {
        const bool has_next = S.next(ui + 1, nxt);
        const char* nA = has_next ? (const char*)g.A + (size_t)nxt.pm * tstepA : cA; const char* nA2 = has_next ? (const char*)g.A2 + (size_t)nxt.pm * tstepA : cA2; const char* nB = has_next ? (const char*)g.Bt + (size_t)nxt.pn * tstep : cB;
        for (int t = 0; t < nt; t += 2) {
            const bool last = (t == nt - 2);
            if constexpr (Epi::MID) { if (t == nt0) E.mid(acc, cur, wr, fr); }
            const char* a1 = PG8_APTR(cA, cA2, t + 1);
            const char* a2 = last ? nA : PG8_APTR(cA, cA2, t + 2); const char* b2 = last ? nB : cB + (size_t)(t + 2) * kstep;
            const char* a3 = a2 + kstep; const char* b3 = b2 + kstep;
            if (last && has_next) S.a_ready(nxt);
            if constexpr (SP2) {
            PG8_LDB(B0, 0, 0); PG8_LDB(B1, 0, 1); PG8_SCHED; PG8_LDA(At, 0, 0); PG8_STAGE(PG8_SA(1, 1), a1 + hstepA, voffA);
            PG8_WAIT_V(8); PG8_WAIT_L(0); PG8_BAR; PG8_MMA(0, 0, At, B0); PG8_MMA(0, 1, At, B1); PG8_BAR; PG8_SCHED;
            PG8_LDA(At, 0, 1); PG8_STAGE(PG8_SB(0, 0), b2, voffB); PG8_STAGE(PG8_SB(0, 1), b2 + hstep, voffB); PG8_STAGE(PG8_SA(0, 0), a2, voffA);
            PG8_WAIT_V(8); PG8_WAIT_L(0); PG8_BAR; PG8_MMA(1, 0, At, B0); PG8_MMA(1, 1, At, B1); PG8_BAR; PG8_SCHED;
            PG8_LDB(B0, 1, 0); PG8_LDB(B1, 1, 1); PG8_SCHED; PG8_LDA(At, 1, 0); PG8_STAGE(PG8_SA(0, 1), a2 + hstepA, voffA);
            PG8_WAIT_V(8); PG8_WAIT_L(0); PG8_BAR; PG8_MMA(0, 0, At, B0); PG8_MMA(0, 1, At, B1); PG8_BAR; PG8_SCHED;
            PG8_LDA(At, 1, 1); PG8_STAGE(PG8_SB(1, 0), b3, voffB); PG8_STAGE(PG8_SB(1, 1), b3 + hstep, voffB); PG8_STAGE(PG8_SA(1, 0), a3, voffA);
            PG8_WAIT_V(8); PG8_WAIT_L(0); PG8_BAR; PG8_MMA(1, 0, At, B0); PG8_MMA(1, 1, At, B1); PG8_BAR; PG8_SCHED;
            } else {
            PG8_LDB(B0, 0, 0); PG8_SCHED; PG8_LDA(At, 0, 0); PG8_STAGE(PG8_SA(1, 1), a1 + hstepA, voffA);
            PG8_WAIT_L(8); PG8_BAR; PG8_WAIT_L(0); PG8_MMA(0, 0, At, B0); PG8_BAR; PG8_SCHED;
            PG8_LDB(B1, 0, 1); PG8_STAGE(PG8_SB(0, 0), b2, voffB);
            PG8_BAR; PG8_WAIT_L(0); PG8_MMA(0, 1, At, B1); PG8_BAR;
            PG8_LDA(At, 0, 1); PG8_STAGE(PG8_SA(0, 0), a2, voffA);
            PG8_BAR; PG8_WAIT_L(0); PG8_MMA(1, 0, At, B0); PG8_BAR; PG8_SCHED;
            PG8_STAGE(PG8_SB(0, 1), b2 + hstep, voffB);
            PG8_WAIT_V(6); PG8_BAR; PG8_MMA(1, 1, At, B1); PG8_BAR;
            PG8_LDB(B0, 1, 0); PG8_SCHED; PG8_LDA(At, 1, 0); PG8_STAGE(PG8_SA(0, 1), a2 + hstepA, voffA);
            PG8_WAIT_L(8); PG8_BAR; PG8_WAIT_L(0); PG8_MMA(0, 0, At, B0); PG8_BAR; PG8_SCHED;
            PG8_LDB(B1, 1, 1); PG8_STAGE(PG8_SB(1, 0), b3, voffB);
            PG8_BAR; PG8_WAIT_L(0); PG8_MMA(0, 1, At, B1); PG8_BAR;
            PG8_LDA(At, 1, 1); PG8_STAGE(PG8_SA(1, 0), a3, voffA);
            PG8_BAR; PG8_WAIT_L(0); PG8_MMA(1, 0, At, B0); PG8_BAR; PG8_SCHED;
            PG8_STAGE(PG8_SB(1, 1), b3 + hstep, voffB);
            PG8_WAIT_V(6); PG8_BAR; PG8_MMA(1, 1, At, B1); PG8_BAR;
            }
        }
        if constexpr (ALIGN_EPI) { if (wr == 0) PG8_BAR; }
        if constexpr (!Epi::AFTER_DRAIN) { E(acc, cur, wr, wc, fr, fq); S.done(cur); }
        if (!has_next) break;
#pragma unroll
        for (int a = 0; a < 2; ++a)
#pragma unroll
            for (int b = 0; b < 2; ++b)
#pragma unroll
                for (int m = 0; m < 4; ++m)
#pragma unroll
                    for (int n = 0; n < 2; ++n) acc[a][b][m][n] = (f32x4){0.f, 0.f, 0.f, 0.f};
        cur = nxt; cA = nA; cA2 = nA2; cB = nB; ++ui;
        if constexpr (Epi::PREF) { int tp_ = threadIdx.x; asm volatile("" : "+v"(tp_)); E.pref(cur, tp_); }
        if constexpr (ALIGN_EPI) { if (wr == 1) PG8_BAR; }
    }
    PG8_WAIT_V(0);
    if constexpr (!ALIGN_EPI) { if (wr == 0) PG8_BAR; }
    PG8_BAR;
#undef PG8_SA
#undef PG8_APTR
#undef PG8_SB
#undef PG8_STAGE
#undef PG8_LDA
#undef PG8_LDB
#undef PG8_MMA
#undef PG8_WAIT_V
#undef PG8_WAIT_L
#undef PG8_BAR
#undef PG8_SCHED
}}

namespace att {
enum { ORDER_NATURAL = 0, ORDER_REVERSED = 1, ORDER_PAIRED = 2, ORDER_XCD = 4 };
constexpr int B = 8, H = 8, HKV = 8, SQ = 4096, SKV = 4096, D = 128;
constexpr int QOFF = 0, WINDOW = SKV;
constexpr float THR = 8.f;
constexpr bool WSKIP = false;
constexpr int OP = 1024;
constexpr int SSQ_STG_OFF = 83968;
constexpr int BIAS_OFF = 67584;
constexpr float SCALE = 0.08838834764831845f;
constexpr int NW = 8, QBLK = 32, KVBLK = 64, QB = NW * QBLK;
constexpr int SHM_V = KVBLK * D * 2, SHM_K = KVBLK * D * 2;
constexpr int LDS_BYTES = 2 * SHM_V + 2 * SHM_K + NW * 64 * 4;
static_assert(D == 128 && SQ % QB == 0 && SKV % KVBLK == 0 && H % HKV == 0 && QOFF >= 0 && QOFF + SQ <= SKV && WINDOW >= 1, "geometry");

using bf16 = __hip_bfloat16;
typedef short bf16x8 __attribute__((ext_vector_type(8)));
typedef short s16x4 __attribute__((ext_vector_type(4)));
typedef float f32x16 __attribute__((ext_vector_type(16)));
typedef float f32x4 __attribute__((ext_vector_type(4)));
typedef unsigned u32x4 __attribute__((ext_vector_type(4)));
template <class A, class Bt> struct same_t { static constexpr bool v = false; };
template <class A> struct same_t<A, A> { static constexpr bool v = true; };

#define KSWZ(row, colB) ((row) * 256 + ((colB) ^ (((row) & 7) << 4)))
#define SBAR() __builtin_amdgcn_sched_barrier(0)
__device__ __forceinline__ int v_st(int k, int c) { const int kk = (k & ~0xC) | ((k & 4) << 1) | ((k & 8) >> 1); return ((kk >> 3) * 4 + (c >> 5)) * 512 + ((kk & 7) * 32 + (c & 31)) * 2; }
__device__ __forceinline__ int v_rd_base(int lane) { return ((lane & 3) << 3) | (((lane >> 2) & 3) << 6) | (((lane >> 4) & 1) << 5) | (((lane >> 5) & 1) << 8); }
constexpr int v_rd_off(int d0, int ks, int half) { return d0 * 512 + ks * 4096 + half * 2048; }
__device__ __forceinline__ int crow(int r, int hi) { return (r & 3) + 8 * (r >> 2) + 4 * hi; }
__device__ __forceinline__ unsigned cvtpk(float lo, float hi) {
    unsigned r; asm volatile("v_cvt_pk_bf16_f32 %0, %1, %2" : "=v"(r) : "v"(lo), "v"(hi)); return r;
}
__device__ __forceinline__ bf16x8 pack8(f32x4 a, f32x4 b) {
    u32x4 w = {cvtpk(a[0], a[1]), cvtpk(a[2], a[3]), cvtpk(b[0], b[1]), cvtpk(b[2], b[3])};
    return *reinterpret_cast<bf16x8*>(&w);
}
template <class T> __device__ __forceinline__ bf16x8 load8(const T* p) {
    if constexpr (same_t<T, float>::v) { return pack8(*(const f32x4*)p, *(const f32x4*)(p + 4)); }
    else { return *reinterpret_cast<const bf16x8*>(p); }
}
__device__ __forceinline__ void mask_tile(f32x16& p0, f32x16& p1, int dq, unsigned W) {
    const float NEG = -__builtin_inff();
#pragma unroll
    for (int r = 0; r < 16; ++r) {
        const int c = (r & 3) + 8 * (r >> 2);
        if ((unsigned)(dq - c) >= W) p0[r] = NEG;
        if ((unsigned)(dq - c - 32) >= W) p1[r] = NEG;
    }
}
__device__ __forceinline__ void partialSM(f32x16& p0, f32x16& p1, float& m_reg, float& mn, float& alpha) {
    float pmax = p0[0]; for (int r = 1; r < 16; ++r) pmax = fmaxf(pmax, p0[r]); for (int r = 0; r < 16; ++r) pmax = fmaxf(pmax, p1[r]);
    { auto rr = __builtin_amdgcn_permlane32_swap(__float_as_uint(pmax), __float_as_uint(pmax), false, false);
      pmax = fmaxf(__uint_as_float(rr[0]), __uint_as_float(rr[1])); }
    constexpr float C2 = 1.4426950408889634f * SCALE;
    if (__builtin_expect(__all((pmax - m_reg) * SCALE <= THR), 1)) { mn = m_reg; alpha = 1.f; }
    else { mn = fmaxf(m_reg, pmax); alpha = __builtin_amdgcn_exp2f((m_reg - mn) * C2); m_reg = mn; }
    const float mnL = -mn * C2;
    for (int r = 0; r < 16; ++r) p0[r] = fmaf(p0[r], C2, mnL); for (int r = 0; r < 16; ++r) p1[r] = fmaf(p1[r], C2, mnL);
    for (int r = 0; r < 16; ++r) p0[r] = __builtin_amdgcn_exp2f(p0[r]);
}
__device__ __forceinline__ void finishSM(f32x16& p0, f32x16& p1, float alpha, float& l_reg, bf16x8& pa0, bf16x8& pa1, bf16x8& pa2, bf16x8& pa3) {
    for (int r = 0; r < 16; ++r) p1[r] = __builtin_amdgcn_exp2f(p1[r]);
    float ps = 0; for (int r = 0; r < 16; ++r) ps += p0[r]; for (int r = 0; r < 16; ++r) ps += p1[r];
    { auto rr = __builtin_amdgcn_permlane32_swap(__float_as_uint(ps), __float_as_uint(ps), false, false);
      ps = __uint_as_float(rr[0]) + __uint_as_float(rr[1]); }
    l_reg = l_reg * alpha + ps;
#define PK4(P, B_, OUT) do { unsigned a0 = cvtpk(P[B_+0], P[B_+1]), a1 = cvtpk(P[B_+2], P[B_+3]);                          \
        unsigned b0 = cvtpk(P[B_+4], P[B_+5]), b1 = cvtpk(P[B_+6], P[B_+7]);                                             \
        auto r0 = __builtin_amdgcn_permlane32_swap(a0, b0, false, false); auto r1 = __builtin_amdgcn_permlane32_swap(a1, b1, false, false); \
        u32x4 w = {r0[0], r1[0], r0[1], r1[1]}; OUT = *reinterpret_cast<bf16x8*>(&w); } while (0)
    PK4(p0, 0, pa0); PK4(p0, 8, pa1); PK4(p1, 0, pa2); PK4(p1, 8, pa3);
#undef PK4
}
template <int KB, bool SK>
__device__ __forceinline__ void qkt(f32x16& p0, f32x16& p1, const char* K_lds, int r32, int hi, const bf16x8* qr, bool act) {
    if (SK && !act) { const float NEG = -__builtin_inff();
#pragma unroll
        for (int r = 0; r < 16; ++r) { p0[r] = NEG; p1[r] = NEG; } return; }
    const char* kb[4];
#pragma unroll
    for (int dd = 0; dd < 4; ++dd) kb[dd] = K_lds + KB * SHM_K + KSWZ(r32, (dd * 16 + hi * 8) * 2);
#pragma unroll
    for (int d0 = 0; d0 < 8; ++d0) { const char* a = kb[d0 & 3] + (d0 >> 2) * 128;
        bf16x8 b0 = *reinterpret_cast<const bf16x8*>(a);
        bf16x8 b1 = *reinterpret_cast<const bf16x8*>(a + 32 * 256);
        p0 = __builtin_amdgcn_mfma_f32_32x32x16_bf16(b0, qr[d0], p0, 0, 0, 0);
        p1 = __builtin_amdgcn_mfma_f32_32x32x16_bf16(b1, qr[d0], p1, 0, 0, 0); }
}
template <int VB, bool SK>
__device__ __forceinline__ void pv_tile(f32x16* o, int vb0, bf16x8 pa0, bf16x8 pa1, bf16x8 pa2, bf16x8 pa3, bool act) {
    if (SK && !act) return;
#define TRRD(dst, off) asm volatile("ds_read_b64_tr_b16 %0, %1 offset:%2" : "=&v"(dst) : "v"(vb0), "i"(off) : "memory")
#define PV_D0(d0) do { s16x4 l0, l1, l2, l3, h0, h1, h2, h3; constexpr int b_ = VB * SHM_V + v_rd_off(d0, 0, 0);     \
        TRRD(l0, b_); TRRD(h0, b_ + 2048); TRRD(l1, b_ + 4096); TRRD(h1, b_ + 6144); TRRD(l2, b_ + 8192); TRRD(h2, b_ + 10240); TRRD(l3, b_ + 12288); TRRD(h3, b_ + 14336); \
        asm volatile("s_waitcnt lgkmcnt(0)" ::: "memory"); SBAR();                 \
        o[d0] = __builtin_amdgcn_mfma_f32_32x32x16_bf16(pa0, (bf16x8){l0[0], l0[1], l0[2], l0[3], h0[0], h0[1], h0[2], h0[3]}, o[d0], 0, 0, 0);   \
        o[d0] = __builtin_amdgcn_mfma_f32_32x32x16_bf16(pa1, (bf16x8){l1[0], l1[1], l1[2], l1[3], h1[0], h1[1], h1[2], h1[3]}, o[d0], 0, 0, 0);   \
        o[d0] = __builtin_amdgcn_mfma_f32_32x32x16_bf16(pa2, (bf16x8){l2[0], l2[1], l2[2], l2[3], h2[0], h2[1], h2[2], h2[3]}, o[d0], 0, 0, 0);   \
        o[d0] = __builtin_amdgcn_mfma_f32_32x32x16_bf16(pa3, (bf16x8){l3[0], l3[1], l3[2], l3[3], h3[0], h3[1], h3[2], h3[3]}, o[d0], 0, 0, 0); } while (0)
    PV_D0(0); PV_D0(1); PV_D0(2); PV_D0(3);
#undef PV_D0
#undef TRRD
}
template <class TIn, class TOut> struct BlockRef { const TIn* Q; const TIn* K; const TIn* V; TOut* O; const float* C; float* SSQ; int P0; int dry; };
template <class TIn> struct Seam {
    bf16x8 qr[8];
    bf16x8 st_v0, st_v1, st_k0, st_k1; f32x4 sf0, sf1, sf2, sf3;
    f32x4 tq[16];
};
__device__ __forceinline__ int swa_jlo(int P0, int W) { const int lowk = P0 - W + 1; return lowk > 0 ? lowk / KVBLK : 0; }
#define ROW(p, k0, rr) ((p) + (size_t)((k0) + (rr)) * D + sc)
#define VMW() asm volatile("s_waitcnt vmcnt(0)" ::: "memory")
#define VMWN(n) asm volatile("s_waitcnt vmcnt(%0)" :: "i"(n) : "memory")
#define SLOAD_H(Kp, Vp, k0) do { S.st_v0 = load8<TIn>(ROW(Vp, k0, sr)); S.st_v1 = load8<TIn>(ROW(Vp, k0, 32 + sr));              \
                         S.st_k0 = load8<TIn>(ROW(Kp, k0, sr)); S.st_k1 = load8<TIn>(ROW(Kp, k0, 32 + sr)); } while (0)
#define SWRITE_HK(bf) do { *(bf16x8*)(K_lds + (bf) * SHM_K + kws) = S.st_k0; *(bf16x8*)(K_lds + (bf) * SHM_K + kws + 32 * 256) = S.st_k1; } while (0)
#define SWRITE_HV(bf) do { *(bf16x8*)(V_lds + (bf) * SHM_V + vst0) = S.st_v0; *(bf16x8*)(V_lds + (bf) * SHM_V + vst1) = S.st_v1; } while (0)
#define SWRITE_H(bf) do { SWRITE_HV(bf); SWRITE_HK(bf); } while (0)
#define SLOAD_F(p, k0) do { S.sf0 = *(const f32x4*)ROW(p, k0, sr); S.sf1 = *(const f32x4*)(ROW(p, k0, sr) + 4);                \
                            S.sf2 = *(const f32x4*)ROW(p, k0, 32 + sr); S.sf3 = *(const f32x4*)(ROW(p, k0, 32 + sr) + 4); } while (0)
#define SWRITE_KF(bf) do { *(bf16x8*)(K_lds + (bf) * SHM_K + kws) = pack8(S.sf0, S.sf1); *(bf16x8*)(K_lds + (bf) * SHM_K + kws + 32 * 256) = pack8(S.sf2, S.sf3); } while (0)
#define SWRITE_VF(bf) do { *(bf16x8*)(V_lds + (bf) * SHM_V + vst0) = pack8(S.sf0, S.sf1); *(bf16x8*)(V_lds + (bf) * SHM_V + vst1) = pack8(S.sf2, S.sf3); } while (0)
template <class TIn, class TOut>
__device__ __forceinline__ void causal_swa_prime(const BlockRef<TIn, TOut>& cur, int W, char* lds, Seam<TIn>& S) {
    constexpr bool F32 = same_t<TIn, float>::v;
    int tid_l = threadIdx.x; asm volatile("" : "+v"(tid_l));
    const int tid = tid_l, wid = __builtin_amdgcn_readfirstlane(tid >> 6), lane = tid & 63, r32 = lane & 31, hi = lane >> 5;
    const int sr = tid >> 4, sc = (tid & 15) * 8, kws = KSWZ(sr, sc * 2); char* K_lds = lds + 2 * SHM_V;
    const int kb0 = ((cur.P0 + QB - 1) / KVBLK) * KVBLK; (void)W;
    for (int d0 = 0; d0 < 8; ++d0) S.qr[d0] = load8<TIn>(cur.Q + (size_t)(wid * QBLK + r32) * D + d0 * 16 + hi * 8);
    if constexpr (F32) { SLOAD_F((const float*)cur.K, kb0); VMW(); SWRITE_KF(0); SBAR(); SLOAD_F((const float*)cur.V, kb0); }
    else { SLOAD_H(cur.K, cur.V, kb0); VMW(); SWRITE_HK(0); }
    __syncthreads();
}
template <class TIn, class TOut>
__device__ __forceinline__ void causal_swa_block(const BlockRef<TIn, TOut>& cur, const BlockRef<TIn, TOut>& nxt, int skv, int W, char* lds, Seam<TIn>& S) {
    constexpr bool F32 = same_t<TIn, float>::v;
    int tid_l = threadIdx.x; asm volatile("" : "+v"(tid_l));
    const int tid = tid_l, wid = __builtin_amdgcn_readfirstlane(tid >> 6), lane = tid & 63, r32 = lane & 31, hi = lane >> 5;
    const int j_lo = swa_jlo(cur.P0, W);
    int j_hi = (cur.P0 + QB - 1) / KVBLK + 1; if (j_hi > skv / KVBLK) j_hi = skv / KVBLK;
    const int NT = j_hi - j_lo;
    const int kbn = ((nxt.P0 + QB - 1) / KVBLK) * KVBLK;
    const int qlo = cur.P0 + wid * QBLK, qm = qlo + r32 - 4 * hi;
    char* V_lds = lds; char* K_lds = lds + 2 * SHM_V;
    float* ws = (float*)(lds + 2 * SHM_V + 2 * SHM_K) + wid * 64; float* li_l = ws, * al_l = ws + 32;
    float m_reg = -1e30f, l_reg = 0; f32x16 o[4] = {};
    const int sr = tid >> 4, sc = (tid & 15) * 8, vst0 = v_st(sr, sc), vst1 = v_st(32 + sr, sc), kws = KSWZ(sr, sc * 2);
    const int vb0 = (int)(uintptr_t)V_lds + v_rd_base(lane);
    const TIn* Kh = cur.K; const TIn* Vh = cur.V;
#define RESC(a) do { if (__any((a) < 1.f)) { if (hi == 0) al_l[r32] = (a); asm volatile("s_waitcnt lgkmcnt(0)" ::: "memory");              \
                     for (int d_ = 0; d_ < 4; ++d_) for (int r = 0; r < 16; ++r) o[d_][r] *= al_l[crow(r, hi)]; } } while (0)
#define KBASE(t) ((j_hi - 1 - (t)) * KVBLK)
#define ACT(t) (KBASE(t) <= qlo + QBLK - 1 && KBASE(t) + KVBLK - 1 >= qlo - W + 1)
#define MASKT(P0_, P1_, t) do { const int kb_ = KBASE(t); if ((!SK || ACT(t)) && (kb_ + KVBLK - 1 > qlo || kb_ <= qlo + QBLK - 1 - W)) mask_tile(P0_, P1_, qm - kb_, (unsigned)W); } while (0)
    constexpr int NQL = F32 ? 16 : 8;
    constexpr bool SK = WSKIP && !F32;
#define SEAM_K0() do { VMWN(NQL + 16); if constexpr (F32) { SWRITE_KF(0); SBAR(); SLOAD_F((const float*)nxt.V, kbn); } else { SWRITE_HK(0); } SBAR(); } while (0)
    f32x16 pA0, pA1, pB0, pB1; float mnA, mnB, alA, alB; bf16x8 pa0, pa1, pa2, pa3;
    int hz = hi; asm volatile("" : "+v"(hz));
#define LOADB(P0_, P1_, t) do { const char* bp_ = (const char*)cur.C + (unsigned)((KBASE(t) + 4 * hz) * 4);                                    \
        _Pragma("unroll") for (int j_ = 0; j_ < 4; ++j_) { const f32x4 b0_ = *(const f32x4*)(bp_ + 32 * j_), b1_ = *(const f32x4*)(bp_ + 128 + 32 * j_); \
            P0_[4*j_] = b0_[0]; P0_[4*j_+1] = b0_[1]; P0_[4*j_+2] = b0_[2]; P0_[4*j_+3] = b0_[3]; P1_[4*j_] = b1_[0]; P1_[4*j_+1] = b1_[1]; P1_[4*j_+2] = b1_[2]; P1_[4*j_+3] = b1_[3]; } } while (0)
    LOADB(pA0, pA1, 0); if (NT > 1) LOADB(pB0, pB1, 1);
    if constexpr (F32) { VMW(); SWRITE_VF(0); SBAR(); } else { SWRITE_HV(0); SBAR(); }
    if (NT > 1) { if constexpr (F32) SLOAD_F((const float*)Kh, KBASE(1)); else SLOAD_H(Kh, Vh, KBASE(1)); }
    SBAR(); qkt<0, SK>(pA0, pA1, K_lds, r32, hi, S.qr, ACT(0));
    if constexpr (F32) { if (NT > 1) { VMW(); SWRITE_KF(1); SBAR(); SLOAD_F((const float*)Vh, KBASE(1)); } }
    MASKT(pA0, pA1, 0); partialSM(pA0, pA1, m_reg, mnA, alA);
    if (NT > 1) { VMW(); if constexpr (F32) { SWRITE_VF(1); SBAR(); if (NT > 2) SLOAD_F((const float*)Kh, KBASE(2)); } else SWRITE_H(1); }
    __syncthreads();
#define HALF_STEP(PX0, PX1, mnX, alX, PY0, PY1, alY, t, KB, VB, SB) do {                                                      \
        SBAR(); qkt<KB, SK>(PX0, PX1, K_lds, r32, hi, S.qr, ACT(t));                                             \
        finishSM(PY0, PY1, alY, l_reg, pa0, pa1, pa2, pa3); SBAR();                                                           \
        if ((t) + 1 < NT) { LOADB(PY0, PY1, (t) + 1); SBAR(); }                                                               \
        if ((t) + 1 < NT) { if constexpr (F32) { VMW(); SWRITE_KF(SB); SBAR(); SLOAD_F((const float*)Vh, KBASE((t) + 1)); }  \
                            else { SLOAD_H(Kh, Vh, KBASE((t) + 1)); } SBAR(); }                                               \
        pv_tile<VB, SK>(o, vb0, pa0, pa1, pa2, pa3, ACT((t) - 1)); MASKT(PX0, PX1, (t)); partialSM(PX0, PX1, m_reg, mnX, alX);                                        \
        __syncthreads();                                                                                                      \
        if ((t) + 1 < NT) { VMW(); if constexpr (F32) { SWRITE_VF(SB); SBAR(); if ((t) + 2 < NT) SLOAD_F((const float*)Kh, KBASE((t) + 2)); } \
                            else { SWRITE_H(SB); } }                                                                          \
        RESC(alX); __syncthreads(); } while (0)
    for (int t = 1; t + 1 < NT; t += 2) {
        HALF_STEP(pB0, pB1, mnB, alB, pA0, pA1, alA, t, 1, 0, 0);
        HALF_STEP(pA0, pA1, mnA, alA, pB0, pB1, alB, t + 1, 0, 1, 1);
    }
    const bool even = (NT & 1) == 0;
    if (even) { SBAR(); qkt<1, SK>(pB0, pB1, K_lds, r32, hi, S.qr, ACT(NT - 1)); SBAR(); }
#define QROW(e) (nxt.Q + (size_t)(wid * QBLK + r32) * D + ((e) >> 1) * 16 + hi * 8 + ((e) & 1) * 4)
    if constexpr (F32) { SLOAD_F((const float*)nxt.K, kbn); SBAR();
#pragma unroll
        for (int e = 0; e < 8; ++e) S.tq[e] = *(const f32x4*)QROW(e); }
    else { SLOAD_H(nxt.K, nxt.V, kbn); SBAR();
#pragma unroll
        for (int d0 = 0; d0 < 8; ++d0) S.qr[d0] = load8<TIn>(nxt.Q + (size_t)(wid * QBLK + r32) * D + d0 * 16 + hi * 8); }
    SBAR();
    finishSM(pA0, pA1, alA, l_reg, pa0, pa1, pa2, pa3); SBAR();
    if constexpr (F32) {
#pragma unroll
        for (int e = 8; e < 16; ++e) S.tq[e] = *(const f32x4*)QROW(e); SBAR(); }
#undef QROW
    pv_tile<0, SK>(o, vb0, pa0, pa1, pa2, pa3, ACT(even ? NT - 2 : NT - 1));
    typedef unsigned u32x2_t __attribute__((ext_vector_type(2)));
    u32x2_t gv[4][4];
    int lz = lane; asm volatile("" : "+v"(lz));
    char* Obw = (char*)cur.O + (size_t)(wid * QBLK) * OP * 2;
#define GLOAD() do { _Pragma("unroll") for (int d0_ = 0; d0_ < 4; ++d0_) _Pragma("unroll") for (int j_ = 0; j_ < 4; ++j_) { const int chunk_ = 64 * j_ + lz; \
        gv[d0_][j_] = *(const u32x2_t*)(Obw + (unsigned)(((chunk_ >> 3) * OP + d0_ * 32 + (chunk_ & 7) * 4) * 2)); } } while (0)
    if (even) { MASKT(pB0, pB1, NT - 1); partialSM(pB0, pB1, m_reg, mnB, alB); __syncthreads(); RESC(alB);
        finishSM(pB0, pB1, alB, l_reg, pa0, pa1, pa2, pa3); SBAR(); GLOAD(); SBAR(); pv_tile<1, SK>(o, vb0, pa0, pa1, pa2, pa3, ACT(NT - 1)); }
    else { SBAR(); GLOAD(); }
    SBAR(); SEAM_K0();
    if (hi == 0) li_l[r32] = l_reg; asm volatile("s_waitcnt lgkmcnt(0)" ::: "memory");
    float rli[16];
#pragma unroll
    for (int r = 0; r < 16; ++r) rli[r] = __builtin_amdgcn_rcpf(li_l[crow(r, hi)]);
    const int rz = lz & 31, hq = lz >> 5;
    float* ost = (float*)(lds + SSQ_STG_OFF) + wid * 1024;
    float* sqp = cur.SSQ + wid * QBLK;
    float s2r[4] = {0.f, 0.f, 0.f, 0.f};
#if PROBE_PHASE == 3 || PROBE_PHASE == 13
    if (!cur.dry)
#endif
#pragma unroll
    for (int d0 = 0; d0 < 4; ++d0) {
#pragma unroll
        for (int r = 0; r < 16; ++r) ost[(4 * hq + (r & 3) + 8 * (r >> 2)) * 32 + rz] = o[d0][r] * rli[r];
        asm volatile("s_waitcnt lgkmcnt(0)" ::: "memory");
#pragma unroll
        for (int j = 0; j < 4; ++j) { const int chunk = 64 * j + lz; const f32x4 vv = *(const f32x4*)(ost + chunk * 4);
            s2r[j] += (vv[0] * vv[0] + vv[1] * vv[1]) + (vv[2] * vv[2] + vv[3] * vv[3]);
            const unsigned g0 = gv[d0][j][0], g1 = gv[d0][j][1]; u32x2_t w;
            w[0] = cvtpk(vv[0] * __uint_as_float(g0 << 16), vv[1] * __uint_as_float(g0 & 0xffff0000u)); w[1] = cvtpk(vv[2] * __uint_as_float(g1 << 16), vv[3] * __uint_as_float(g1 & 0xffff0000u));
            *(u32x2_t*)(Obw + (unsigned)(((chunk >> 3) * OP + d0 * 32 + (chunk & 7) * 4) * 2)) = w; }
        asm volatile("s_waitcnt lgkmcnt(0)" ::: "memory");
    }
#pragma unroll
    for (int j = 0; j < 4; ++j) { float t = s2r[j]; t += __shfl_xor(t, 1); t += __shfl_xor(t, 2); t += __shfl_xor(t, 4);
#if PROBE_PHASE == 3 || PROBE_PHASE == 13
        if ((lz & 7) == 0 && !cur.dry) sqp[8 * j + (lz >> 3)] = t; }
#else
        if ((lz & 7) == 0) sqp[8 * j + (lz >> 3)] = t; }
#endif
    if constexpr (F32) {
#pragma unroll
        for (int d0 = 0; d0 < 8; ++d0) S.qr[d0] = pack8(S.tq[2 * d0], S.tq[2 * d0 + 1]); }
    __syncthreads();
#undef RESC
#undef LOADB
#undef GLOAD
#undef KBASE
#undef ACT
#undef MASKT
#undef SEAM_K0
#undef HALF_STEP
}
#undef ROW
#undef VMW
#undef VMWN
#undef SLOAD_H
#undef SWRITE_HK
#undef SWRITE_HV
#undef SWRITE_H
#undef SLOAD_F
#undef SWRITE_KF
#undef SWRITE_VF

__host__ __device__ inline int swa_nramp(int nqb, int W, int qoff) { const int t = W - 1 - qoff; const int n = t < 0 ? 0 : t / QB + 1; return n > nqb ? nqb : n; }
__host__ __device__ inline int swa_nx(int nqb, int nramp, int order) { return (order & ORDER_PAIRED) ? (nramp + 1) / 2 + (nqb - nramp) : nqb; }
struct SwaItem { int bh, qb0, qb1; };
__device__ __forceinline__ SwaItem swa_decode(int L, int nb, int nh, int nhkv, int nqb, int nx, int nramp, int order) {
    const int G = nh / nhkv; SwaItem it; int x;
    if ((order & ORDER_XCD) && (nb * nhkv) % 8 == 0) { const int xcd = L & 7, k = L >> 3, per = G * nx, gi = k / per, r = k - gi * per;
        it.bh = (gi * 8 + xcd) * G + r / nx; x = r % nx; }
    else { it.bh = L / nx; x = L - it.bh * nx; }
    if (order & ORDER_PAIRED) { const int ns = nqb - nramp;
        if (x < ns) { it.qb0 = it.qb1 = nqb - 1 - x; } else { it.qb0 = x - ns; it.qb1 = nramp - 1 - it.qb0; } }
    else { it.qb0 = it.qb1 = ((order & 3) == ORDER_REVERSED) ? nqb - 1 - x : x; }
    return it;
}}

#define LAS __attribute__((address_space(3)))
typedef unsigned short bf16u;
typedef float f32x4 __attribute__((ext_vector_type(4)));
typedef unsigned v4u __attribute__((ext_vector_type(4)));
typedef unsigned v2u __attribute__((ext_vector_type(2)));
typedef short bf16x8 __attribute__((ext_vector_type(8)));
typedef float f32x16 __attribute__((ext_vector_type(16)));
#define LDS_WAIT() asm volatile("s_waitcnt lgkmcnt(0)" ::: "memory")
#define XB_TMO      128
#define XB_XCNT(j)  (256  + 64 * (j))
#define XB_XSUB(j)  (1280 + 64 * (j))
#define XB_XGEN(j)  (2304 + 64 * (j))
#define XB_TOP      3328
#define XB_TOPGEN   3392
#define XCD_BAR_WORDS 3456
#define XB_SPIN_CAP (1u << 18)

__device__ __forceinline__ unsigned xb_ld(unsigned* p)              { return __hip_atomic_load(p, __ATOMIC_RELAXED, __HIP_MEMORY_SCOPE_AGENT); }
__device__ __forceinline__ unsigned xb_add(unsigned* p, unsigned v) { return __hip_atomic_fetch_add(p, v, __ATOMIC_RELAXED, __HIP_MEMORY_SCOPE_AGENT); }
__device__ __forceinline__ unsigned xb_xcc_id() { return (unsigned)__builtin_amdgcn_s_getreg((3 << 11) | 20) & 0xFu; }
#define XB_SPIN(cond, bar) do { unsigned _sp = 0; while (cond) { __builtin_amdgcn_s_sleep(1); \
    if ((++_sp & 255u) == 0u) { if (xb_ld(&(bar)[XB_TMO])) break; if (_sp > XB_SPIN_CAP) { atomicAdd(&(bar)[XB_TMO], 1u); break; } } } } while (0)

struct XcdBarrier {
    unsigned* bar; unsigned x;
    volatile LAS unsigned* st;
};

__device__ __forceinline__ XcdBarrier xcd_barrier_post(unsigned* bar, volatile LAS unsigned* st) {
    XcdBarrier b; b.bar = bar; b.x = xb_xcc_id(); b.st = st;
    if (threadIdx.x == 0) (void)xb_add(&bar[XB_XCNT(b.x)], 1u);
    return b;
}
__device__ __forceinline__ void xcd_barrier_complete(unsigned* bar, unsigned x, unsigned& nloc, unsigned& nx) {
    const unsigned G = gridDim.x * gridDim.y * gridDim.z;
    unsigned sum, cnt, mine, sp = 0u;
    for (;;) {
        sum = 0u; cnt = 0u; mine = 0u;
#pragma unroll
        for (unsigned j = 0; j < 16; ++j) { const unsigned c = xb_ld(&bar[XB_XCNT(j)]); sum += c; cnt += (c > 0u) ? 1u : 0u; mine = (j == x) ? c : mine; }
        if (sum == G) break;
        __builtin_amdgcn_s_sleep(1);
        if ((++sp & 255u) == 0u) { if (xb_ld(&bar[XB_TMO])) break; if (sp > XB_SPIN_CAP) { atomicAdd(&bar[XB_TMO], 1u); break; } }
    }
    nloc = mine > 0u ? mine : 1u; nx = cnt > 0u ? cnt : 1u;
}

__device__ __forceinline__ void xcd_barrier(const XcdBarrier& b) {
    asm volatile("s_waitcnt vmcnt(0)" ::: "memory");
    __syncthreads();
    if (threadIdx.x == 0) {
        unsigned* bar = b.bar;
        __builtin_amdgcn_s_waitcnt(0);
        unsigned nloc = b.st[0], nx = b.st[1];
        if (nloc == 0u) { xcd_barrier_complete(bar, b.x, nloc, nx); b.st[0] = nloc; b.st[1] = nx; }
        const unsigned old = xb_add(&bar[XB_XSUB(b.x)], 1u);
        const unsigned gen = old / nloc;
        if (old + 1u == (gen + 1u) * nloc) {
            __builtin_amdgcn_fence(__ATOMIC_RELEASE, "agent");
            asm volatile("s_waitcnt vmcnt(0)" ::: "memory");
            const unsigned og = xb_add(&bar[XB_TOP], 1u);
            const unsigned tg = og / nx;
            if (og + 1u == (tg + 1u) * nx) xb_add(&bar[XB_TOPGEN], 1u);
            else XB_SPIN(xb_ld(&bar[XB_TOPGEN]) == tg, bar);
            __builtin_amdgcn_fence(__ATOMIC_ACQUIRE, "agent");
            xb_add(&bar[XB_XGEN(b.x)], 1u);
            asm volatile("s_waitcnt vmcnt(0)" ::: "memory");
        } else {
            XB_SPIN(xb_ld(&bar[XB_XGEN(b.x)]) == gen, bar);
            __builtin_amdgcn_fence(__ATOMIC_ACQUIRE, "agent");
            asm volatile("s_waitcnt vmcnt(0)" ::: "memory");
        }
    }
    __syncthreads();
}

constexpr int M = 32768, DM = 1024, SEQ = 4096, NB = 8, NH = 8, DIN = 6152, N1 = 6144, DPLE = 256;
constexpr size_t MiB = 1u << 20;
constexpr size_t WS_SSQ = 0;
constexpr size_t WS_PSA = 488 * MiB;
constexpr size_t WS_PSL = 489 * MiB;
constexpr size_t WS_PSM = 493 * MiB;
constexpr size_t WS_PSE = 495 * MiB;
constexpr size_t WS_RSX = 512 * 1024;
constexpr size_t WS_BAR = 640 * 1024, BAR_BYTES = 16384;
constexpr size_t WS_LS = 1 * MiB;
constexpr size_t WS_C = 2 * MiB;
constexpr size_t WS_WRT = 3 * MiB, WS_WIT = 3 * MiB + 256 * 1024, WS_WPLE = 3 * MiB + 512 * 1024;
constexpr size_t WS_W1 = 4 * MiB, WS_WOUT = 16 * MiB, WS_WG = 20 * MiB, WS_PB = 24 * MiB, WS_XN = 40 * MiB;
constexpr size_t WS_Q = 104 * MiB, WS_K = 168 * MiB, WS_V = 232 * MiB, WS_YA = 296 * MiB, WS_XL = 360 * MiB, WS_YL = 424 * MiB, WS_END = 497 * MiB;
constexpr size_t WS_EP = WS_Q, WS_MIX = WS_K;
constexpr int LDS_BYTES = 163840;

struct Params { const float* in[20]; float* out; unsigned char* ws; int lo, hi; };

__device__ __forceinline__ float wave_sum(float v) {
#pragma unroll
    for (int o = 1; o < 64; o <<= 1) v += __shfl_xor(v, o);
    return v;
}
__device__ __forceinline__ unsigned pk2(float lo, float hi) { return pg8::cvt_pk_bf16(lo, hi); }
typedef _Float16 h16x8 __attribute__((ext_vector_type(8)));
__device__ __forceinline__ unsigned pkh2(float lo, float hi) { return pg8::cvt_pk_f16(lo, hi); }

__device__ __forceinline__ void tr_item(const float* W, int ldw, int nblk, bf16u* WT, int Kt, int koff, int row_off, const float* ksc, bool recip, LAS float* scr, int item, int lane, bool f16out = false) {
    const int kb = item / nblk, nb = item % nblk, k0 = 64 * kb, n0 = 32 * nb;
    float wv[32];
#pragma unroll
    for (int i = 0; i < 32; ++i) wv[i] = W[(size_t)(k0 + 2 * i + (lane >> 5)) * ldw + n0 + (lane & 31)];
    if (ksc) { float sv[32];
#pragma unroll
        for (int i = 0; i < 32; ++i) sv[i] = ksc[k0 + 2 * i + (lane >> 5)];
#pragma unroll
        for (int i = 0; i < 32; ++i) wv[i] *= recip ? 1.0f / sv[i] : sv[i]; }
#pragma unroll
    for (int i = 0; i < 32; ++i) scr[(2 * i + (lane >> 5)) * 33 + (lane & 31)] = wv[i];
    LDS_WAIT(); asm volatile("" ::: "memory");
    const int c = lane & 7;
#pragma unroll
    for (int j = 0; j < 4; ++j) { const int n = (lane >> 3) + 8 * j; const LAS float* s = scr + (8 * c) * 33 + n;
        v4u o; if (f16out) { o.x = pkh2(s[0 * 33], s[1 * 33]); o.y = pkh2(s[2 * 33], s[3 * 33]); o.z = pkh2(s[4 * 33], s[5 * 33]); o.w = pkh2(s[6 * 33], s[7 * 33]); }
        else { o.x = pk2(s[0 * 33], s[1 * 33]); o.y = pk2(s[2 * 33], s[3 * 33]); o.z = pk2(s[4 * 33], s[5 * 33]); o.w = pk2(s[6 * 33], s[7 * 33]); }
        *(v4u*)(WT + (size_t)(row_off + n0 + n) * Kt + koff + k0 + 8 * c) = o; }
    LDS_WAIT(); asm volatile("" ::: "memory");
}

__device__ __forceinline__ void p0_phase(const Params& P, unsigned char* lds) {
    int tid_l = threadIdx.x; asm volatile("" : "+v"(tid_l));
    const int tid = tid_l, lane = tid & 63, wid = __builtin_amdgcn_readfirstlane(tid >> 6), G = gridDim.x;
    unsigned char* ws = P.ws;
    LAS float* scr = (LAS float*)((LAS unsigned char*)lds + wid * 8448);
    LAS float* wfl = (LAS float*)((LAS unsigned char*)lds + 67584);
    const float* w_in = P.in[2];
    { float wt[16];
#pragma unroll
      for (int j = 0; j < 16; ++j) { const int i = tid + 512 * j; wt[j] = w_in[(size_t)(i >> 3) * DIN + 3072 + (i & 7)]; }
#pragma unroll
      for (int j = 0; j < 16; ++j) { const int i = tid + 512 * j; wfl[(i & 7) * 1024 + (i >> 3)] = wt[j]; } }
    const int gid = blockIdx.x * 512 + tid, NT = G * 512;
    const int gw = blockIdx.x * 8 + wid, NGW = G * 8;
    bf16u* W1t = (bf16u*)(ws + WS_W1); bf16u* Wot = (bf16u*)(ws + WS_WOUT); bf16u* Wgt = (bf16u*)(ws + WS_WG); bf16u* Wpt = (bf16u*)(ws + WS_WPLE);
    bf16u* WrT = (bf16u*)(ws + WS_WRT); bf16u* WiT = (bf16u*)(ws + WS_WIT);
    for (int it = gw; it < 5376; it += NGW) {
        int r = it; const float* W; int ldw, nblk, Kt, koff = 0, row_off = 0, item; bf16u* WT; const float* ksc = nullptr; bool recip = false, f16o = false;
        if (r < 3072) { const int hf = r >= 1536; item = r - hf * 1536; W = w_in + hf * 3080; ldw = DIN; nblk = 96; WT = W1t; Kt = 1024; row_off = hf * 3072; }
        else if ((r -= 3072) < 1024) { const int hf = r >= 512; item = r - hf * 512; W = P.in[15] + (size_t)hf * 1024 * 1024; ldw = 1024; nblk = 32; WT = Wot; Kt = 2048; koff = hf * 1024; ksc = hf ? P.in[14] : P.in[13]; }
        else if ((r -= 1024) < 1024) { const int hf = r >= 512; item = r - hf * 512; W = P.in[18]; ldw = 1024; nblk = 32; WT = Wgt; Kt = 2048; koff = hf * 1024; ksc = hf ? P.in[5] : P.in[4]; recip = !hf; }
        else if ((r -= 1024) < 128) { item = r; W = P.in[16]; ldw = 1024; nblk = 32; WT = Wpt; Kt = 256; }
        else { r -= 128; const int gi = r >= 64; r -= gi * 64; item = r & 7; W = (gi ? P.in[10] : P.in[8]) + (r >> 3) * 16384; ldw = 128; nblk = 4; WT = gi ? WiT : WrT; Kt = 128; row_off = (r >> 3) * 128; f16o = true; }
        tr_item(W, ldw, nblk, WT, Kt, koff, row_off, ksc, recip, scr, item, lane, f16o);
    }
    { const f32x4* p4 = (const f32x4*)P.in[1]; v4u* o = (v4u*)(ws + WS_PB);
      for (int i = gid; i < M * DPLE / 8; i += 4 * NT) { f32x4 a[4], b[4];
#pragma unroll
          for (int k = 0; k < 4; ++k) { const int ii = i + k * NT; const int jj = ii < M * DPLE / 8 ? ii : i; a[k] = p4[2 * jj]; b[k] = p4[2 * jj + 1]; }
#pragma unroll
          for (int k = 0; k < 4; ++k) { const int ii = i + k * NT; if (ii < M * DPLE / 8) { v4u w; w.x = pk2(a[k][0], a[k][1]); w.y = pk2(a[k][2], a[k][3]); w.z = pk2(b[k][0], b[k][1]); w.w = pk2(b[k][2], b[k][3]); o[ii] = w; } } } }
    __syncthreads();
    const float* x = P.in[0]; bf16u* XN = (bf16u*)(ws + WS_XN); float* RSX = (float*)(ws + WS_RSX); float* LS = (float*)(ws + WS_LS);
    f32x4 pg[4];
#pragma unroll
    for (int j = 0; j < 4; ++j) pg[j] = *((const f32x4*)P.in[4] + lane + 64 * j);
    const float bfl = lane < 8 ? P.in[3][lane] : 0.f;
    for (int m0 = gw; m0 < M; m0 += 4 * NGW) {
        f32x4 vr[4][4];
#pragma unroll
        for (int rr = 0; rr < 4; ++rr) { const int mm = m0 + rr * NGW; const f32x4* xa = (const f32x4*)(x + (size_t)(mm < M ? mm : m0) * DM) + lane;
#pragma unroll
            for (int j = 0; j < 4; ++j) vr[rr][j] = xa[64 * j]; }
#pragma unroll
        for (int rr = 0; rr < 4; ++rr) {
            const int m = m0 + rr * NGW; if (m >= M) break;
            f32x4 v[4]; float ss = 0.f;
#pragma unroll
            for (int j = 0; j < 4; ++j) { v[j] = vr[rr][j]; ss += (v[j][0] * v[j][0] + v[j][1] * v[j][1]) + (v[j][2] * v[j][2] + v[j][3] * v[j][3]); }
            ss = wave_sum(ss);
            const float var = ss * (1.0f / DM) + 1e-6f, rstd = 1.0f / sqrtf(var);
            v2u* o8 = (v2u*)(XN + (size_t)m * DM) + lane;
#pragma unroll
            for (int j = 0; j < 4; ++j) { v[j] = v[j] * rstd * pg[j]; v2u w; w.x = pk2(v[j][0], v[j][1]); w.y = pk2(v[j][2], v[j][3]); o8[64 * j] = w; }
            float f[8];
#pragma unroll
            for (int h = 0; h < 8; ++h) { float a = 0.f;
#pragma unroll
                for (int j = 0; j < 4; ++j) { const f32x4 w = *(const LAS f32x4*)(wfl + h * 1024 + 256 * j + 4 * lane); a += (v[j][0] * w[0] + v[j][1] * w[1]) + (v[j][2] * w[2] + v[j][3] * w[3]); }
                f[h] = wave_sum(a); }
            float z = f[0];
#pragma unroll
            for (int h = 1; h < 8; ++h) z = (lane == h) ? f[h] : z;
            z += bfl;
            const float ls = fminf(z, 0.f) - log1pf(__expf(-fabsf(z)));
            if (lane < 8) LS[(size_t)(((m >> 12) * 8 + lane)) * SEQ + (m & 4095)] = ls;
            if (lane == 8) RSX[m] = sqrtf(var);
        }
    }
}

__device__ __forceinline__ void cumsum_phase(const Params& P) {
    int tid_l = threadIdx.x; asm volatile("" : "+v"(tid_l));
    const int tid = tid_l, lane = tid & 63, wid = tid >> 6;
    if (wid != 0) return;
    const float* LS = (const float*)(P.ws + WS_LS); float* C = (float*)(P.ws + WS_C);
    for (int bh = blockIdx.x; bh < 64; bh += gridDim.x) {
        const f32x4* src = (const f32x4*)(LS + (size_t)bh * SEQ + lane * 64); f32x4 v[16]; double tot = 0.0;
#pragma unroll
        for (int i = 0; i < 16; ++i) { v[i] = src[i]; tot += ((double)v[i][0] + (double)v[i][1]) + ((double)v[i][2] + (double)v[i][3]); }
        double inc = tot;
#pragma unroll
        for (int o = 1; o < 64; o <<= 1) { const double t = __shfl_up(inc, o); if (lane >= o) inc += t; }
        double run = inc - tot; constexpr double NRS = -11.313708498984761;
        f32x4* dst = (f32x4*)(C + (size_t)bh * SEQ + lane * 64);
#pragma unroll
        for (int i = 0; i < 16; ++i) { f32x4 o; run += (double)v[i][0]; o[0] = (float)(run * NRS); run += (double)v[i][1]; o[1] = (float)(run * NRS); run += (double)v[i][2]; o[2] = (float)(run * NRS); run += (double)v[i][3]; o[3] = (float)(run * NRS); dst[i] = o; }
    }
}

#define XSWZ(row, colB) ((row) * 256 + ((colB) ^ (((row) & 7) << 4)))
__device__ __forceinline__ int crow16(int r, int hi) { return (r & 3) + 8 * (r >> 2) + 4 * hi; }
__device__ __forceinline__ void lru_phase(const Params& P, unsigned char* lds_g, const bool dry) {
    int tid_l = threadIdx.x; asm volatile("" : "+v"(tid_l));
    const int tid = tid_l, lane = tid & 63, wid = __builtin_amdgcn_readfirstlane(tid >> 6), r32 = lane & 31, hi = lane >> 5;
    LAS unsigned char* lds = (LAS unsigned char*)lds_g;
    LAS unsigned char* XC = lds;
    LAS float* AS = (LAS float*)(lds + 65536);
    LAS float* US = (LAS float*)(lds + 98304);
    LAS float* SEG = (LAS float*)(lds + 131072); LAS float* CW = SEG + 2048; LAS unsigned char* WRS = lds + 141824; LAS unsigned char* WIS = lds + 150016;
    const bf16u* XL = (const bf16u*)(P.ws + WS_XL); bf16u* YL = (bf16u*)(P.ws + WS_YL); float* psl = (float*)(P.ws + WS_PSL);
    const bf16u* WrT = (const bf16u*)(P.ws + WS_WRT); const bf16u* WiT = (const bf16u*)(P.ws + WS_WIT);
    const int cgp = tid & 15, run = tid >> 4;
    const int ch = tid & 31, seg = tid >> 5;
    const int otok = tid >> 1, ohalf = tid & 1;
    for (int item = blockIdx.x; item < 256; item += gridDim.x) {
        const int jq = (item >> 3) & 3, grp = (item & 7) | ((item >> 5) << 3), b = grp >> 3, n = grp & 7;
        __syncthreads();
        for (int i = tid; i < 640; i += 512) CW[i] = i < 512 ? P.in[6][(i >> 7) * 1024 + n * 128 + (i & 127)] : P.in[7][n * 128 + (i - 512)];
        { const int wrow = tid >> 4, wch = tid & 15; const size_t o = (size_t)(n * 128 + jq * 32 + wrow) * 128 + wch * 8;
          *(LAS v4u*)(WRS + XSWZ(wrow, wch * 16)) = *(const v4u*)(WrT + o); *(LAS v4u*)(WIS + XSWZ(wrow, wch * 16)) = *(const v4u*)(WiT + o); }
        const int co = n * 128 + jq * 32 + ch;
        constexpr float L2E = 1.4426950408889634f;
        const float sp8 = 8.0f * log1pf(__expf(-P.in[12][co])), cbr = -P.in[9][co] * L2E, cbi = -P.in[11][co] * L2E, k1 = -sp8 * L2E, k2 = -2.0f * sp8;
        float carry = 0.f;
        const char* xlb = (const char*)(XL + (size_t)(b * SEQ) * DM + n * 128);
        char* ylb = (char*)(YL + (size_t)(b * SEQ) * DM + n * 128 + jq * 32);
        const unsigned xoff = (unsigned)((run * 8) * DM + cgp * 8) * 2u, yoff = (unsigned)(otok * DM + ohalf * 16) * 2u;
        v4u rows[11];
#pragma unroll
        for (int i = 0; i < 11; ++i) { const int s = run * 8 - 3 + i; const unsigned o = (unsigned)((s < 0 ? 0 : s) * DM + cgp * 8) * 2u; v4u v = *(const v4u*)(xlb + o); if (s < 0) v = (v4u){0u, 0u, 0u, 0u}; rows[i] = v; }
        __syncthreads();
        h16x8 w8[4], bb8;
#pragma unroll
        for (int j = 0; j < 4; ++j) { const f32x4 a = *(const LAS f32x4*)(CW + j * 128 + cgp * 8), c = *(const LAS f32x4*)(CW + j * 128 + cgp * 8 + 4);
            w8[j] = (h16x8){(_Float16)a[0], (_Float16)a[1], (_Float16)a[2], (_Float16)a[3], (_Float16)c[0], (_Float16)c[1], (_Float16)c[2], (_Float16)c[3]}; }
        { const f32x4 a = *(const LAS f32x4*)(CW + 512 + cgp * 8), c = *(const LAS f32x4*)(CW + 512 + cgp * 8 + 4);
            bb8 = (h16x8){(_Float16)a[0], (_Float16)a[1], (_Float16)a[2], (_Float16)a[3], (_Float16)c[0], (_Float16)c[1], (_Float16)c[2], (_Float16)c[3]}; }
#pragma unroll 1
        for (int chunk = 0; chunk < 16; ++chunk) {
            const int t0 = chunk * 256;
            LAS float* SEGA = SEG + (chunk & 1) * 1024; LAS float* SEGB = SEGA + 512;
            int tz = tid; asm volatile("" : "+v"(tz));
            const int lane = tz & 63, r32 = lane & 31, hi = lane >> 5, cgp = tz & 15, run = tz >> 4, ch = tz & 31, seg = tz >> 5, otok = tz >> 1, ohalf = tz & 1;
            const unsigned xoff = (unsigned)((run * 8) * DM + cgp * 8) * 2u, yoff = (unsigned)(otok * DM + ohalf * 16) * 2u;
#ifdef NO_PREF
            if (chunk > 0) {
#pragma unroll
                for (int i = 0; i < 11; ++i) rows[i] = *(const v4u*)(xlb + (xoff + (unsigned)((t0 + i - 3) * DM * 2)));
            }
#endif
            {
#pragma unroll
              for (int hf = 0; hf < 2; ++hf) { h16x8 y8[4];
#pragma unroll
                  for (int tk = 0; tk < 4; ++tk) y8[tk] = bb8;
#pragma unroll
                  for (int i = 0; i < 7; ++i) { const h16x8 x8 = __builtin_bit_cast(h16x8, rows[hf * 4 + i]);
#pragma unroll
                      for (int tk = 0; tk < 4; ++tk) { const int j = i - tk; if (j >= 0 && j < 4) y8[tk] = w8[j] * x8 + y8[tk]; } }
#pragma unroll
                  for (int tk = 0; tk < 4; ++tk) *(LAS v4u*)(XC + XSWZ(run * 8 + hf * 4 + tk, cgp * 16)) = __builtin_bit_cast(v4u, y8[tk]); } }
#ifndef NO_PREF
            if (chunk + 1 < 16) {
#pragma unroll
                for (int i = 0; i < 11; ++i) rows[i] = *(const v4u*)(xlb + (xoff + (unsigned)((t0 + 256 + i - 3) * DM * 2)));
            }
#endif
            LDS_WAIT();
            f32x16 R = {}, I = {};
#pragma unroll
            for (int kk = 0; kk < 8; ++kk) { const h16x8 a = *(const LAS h16x8*)(XC + XSWZ(wid * 32 + r32, (kk * 16 + hi * 8) * 2));
                const h16x8 wr_ = *(const LAS h16x8*)(WRS + XSWZ(r32, (kk * 16 + hi * 8) * 2)), wi_ = *(const LAS h16x8*)(WIS + XSWZ(r32, (kk * 16 + hi * 8) * 2));
                R = __builtin_amdgcn_mfma_f32_32x32x16_f16(a, wr_, R, 0, 0, 0); I = __builtin_amdgcn_mfma_f32_32x32x16_f16(a, wi_, I, 0, 0, 0); }
            const unsigned yo = yoff + (unsigned)(t0 * DM * 2);
            const v4u g0 = *(const v4u*)(ylb + yo), g1 = *(const v4u*)(ylb + yo + 16);
            { typedef float f32x2 __attribute__((ext_vector_type(2)));
              const int colB = (jq * 32 + r32) * 2; const f32x2 one2 = (f32x2){1.0f, 1.0f};
#pragma unroll
              for (int r = 0; r < 16; r += 2) { const int tok = wid * 32 + crow16(r, hi);
                const f32x2 rr = (f32x2){R[r], R[r + 1]}, ii = (f32x2){I[r], I[r + 1]};
                const unsigned short xb0 = *(const LAS unsigned short*)(XC + XSWZ(tok, colB & ~15) + (colB & 15)), xb1 = *(const LAS unsigned short*)(XC + XSWZ(tok + 1, colB & ~15) + (colB & 15));
                const f32x2 xcv = (f32x2){(float)__builtin_bit_cast(_Float16, xb0), (float)__builtin_bit_cast(_Float16, xb1)};
                f32x2 t1 = rr * (-L2E) + cbr, t2 = ii * (-L2E) + cbi;
                t1.x = fminf(t1.x, 60.f); t1.y = fminf(t1.y, 60.f); t2.x = fminf(t2.x, 60.f); t2.y = fminf(t2.y, 60.f);
                const f32x2 e1 = (f32x2){__builtin_amdgcn_exp2f(t1.x), __builtin_amdgcn_exp2f(t1.y)}, e2 = (f32x2){__builtin_amdgcn_exp2f(t2.x), __builtin_amdgcn_exp2f(t2.y)};
                const f32x2 d1 = e1 + one2, d2 = e2 + one2, dd = d1 * d2;
                const f32x2 rinv = (f32x2){__builtin_amdgcn_rcpf(dd.x), __builtin_amdgcn_rcpf(dd.y)}, rg = rinv * d2, ig = rinv * d1;
                const f32x2 la2 = rg * k1, x = rg * k2;
                const f32x2 a = (f32x2){__builtin_amdgcn_exp2f(la2.x), __builtin_amdgcn_exp2f(la2.y)};
                f32x2 pz = x * (1.0f / 720.0f) + (1.0f / 120.0f); pz = pz * x + (1.0f / 24.0f); pz = pz * x + (1.0f / 6.0f); pz = pz * x + 0.5f; pz = pz * x + one2;
                const f32x2 ms = -(x * pz), mb = one2 - a * a;
                const f32x2 m2 = (f32x2){x.x > -0.25f ? ms.x : mb.x, x.y > -0.25f ? ms.y : mb.y};
                const f32x2 u = (f32x2){__builtin_amdgcn_sqrtf(m2.x), __builtin_amdgcn_sqrtf(m2.y)} * ig * xcv;
                AS[tok * 32 + r32] = a.x; US[tok * 32 + r32] = u.x; AS[(tok + 1) * 32 + r32] = a.y; US[(tok + 1) * 32 + r32] = u.y; } }
            LDS_WAIT();
            float av[16], uv[16];
#pragma unroll
            for (int i = 0; i < 16; ++i) { av[i] = AS[(seg * 16 + i) * 32 + ch]; uv[i] = US[(seg * 16 + i) * 32 + ch]; }
            { float A = 1.f, h = 0.f;
#pragma unroll
              for (int i = 0; i < 16; ++i) { h = av[i] * h + uv[i]; A *= av[i]; }
              SEGA[seg * 32 + ch] = A; SEGB[seg * 32 + ch] = h; }
            asm volatile("s_waitcnt lgkmcnt(0)\n\ts_barrier" ::: "memory");
            { float sa[16], sb[16];
#pragma unroll
              for (int s = 0; s < 16; ++s) { sa[s] = SEGA[s * 32 + ch]; sb[s] = SEGB[s * 32 + ch]; }
              float c = carry, cin = carry;
#pragma unroll
              for (int s = 0; s < 16; ++s) { cin = (s == seg) ? c : cin; c = sa[s] * c + sb[s]; }
              carry = c;
              float h = cin;
#pragma unroll
              for (int i = 0; i < 16; ++i) { h = av[i] * h + uv[i]; US[(seg * 16 + i) * 32 + ch] = h; } }
            LDS_WAIT();
            { const LAS f32x4* hp = (const LAS f32x4*)(US + otok * 32 + ohalf * 16); const f32x4 h0 = hp[0], h1 = hp[1], h2 = hp[2], h3 = hp[3];
              float s2 = (h0[0] * h0[0] + h0[1] * h0[1]) + (h0[2] * h0[2] + h0[3] * h0[3]) + (h1[0] * h1[0] + h1[1] * h1[1]) + (h1[2] * h1[2] + h1[3] * h1[3])
                       + (h2[0] * h2[0] + h2[1] * h2[1]) + (h2[2] * h2[2] + h2[3] * h2[3]) + (h3[0] * h3[0] + h3[1] * h3[1]) + (h3[2] * h3[2] + h3[3] * h3[3]);
              v4u o0, o1;
              o0.x = pk2(h0[0] * pg8::bf_lo(g0.x), h0[1] * pg8::bf_hi(g0.x)); o0.y = pk2(h0[2] * pg8::bf_lo(g0.y), h0[3] * pg8::bf_hi(g0.y));
              o0.z = pk2(h1[0] * pg8::bf_lo(g0.z), h1[1] * pg8::bf_hi(g0.z)); o0.w = pk2(h1[2] * pg8::bf_lo(g0.w), h1[3] * pg8::bf_hi(g0.w));
              o1.x = pk2(h2[0] * pg8::bf_lo(g1.x), h2[1] * pg8::bf_hi(g1.x)); o1.y = pk2(h2[2] * pg8::bf_lo(g1.y), h2[3] * pg8::bf_hi(g1.y));
              o1.z = pk2(h3[0] * pg8::bf_lo(g1.z), h3[1] * pg8::bf_hi(g1.z)); o1.w = pk2(h3[2] * pg8::bf_lo(g1.w), h3[3] * pg8::bf_hi(g1.w));
              s2 += __shfl_xor(s2, 1);
              if (!dry) { *(v4u*)(ylb + yo) = o0; *(v4u*)(ylb + yo + 16) = o1;
                if (ohalf == 0) psl[(size_t)(n * 4 + jq) * M + b * SEQ + t0 + otok] = s2; } }
        }
    }
    __syncthreads();
}

__device__ __forceinline__ void attn_phase(const Params& P, unsigned char* lds_g, const int dry) {
    using namespace att;
    typedef __hip_bfloat16 T;
    char* lds = (char*)lds_g;
    const T* Qb = (const T*)(P.ws + WS_Q); const T* Kb = (const T*)(P.ws + WS_K); const T* Vb = (const T*)(P.ws + WS_V); T* YA = (T*)(P.ws + WS_YA);
    const float* Cb = (const float*)(P.ws + WS_C); float* psa = (float*)(P.ws + WS_PSA);
    constexpr int order = ORDER_PAIRED | ORDER_XCD, nqb = SQ / QB, nramp = nqb, nx = (nramp + 1) / 2, total = nx * B * H;
    const int stride = gridDim.x;
    int L = blockIdx.x; if (L >= total) return;
#define MKREF(it_, pass_) ({ const int qb_ = (pass_) ? (it_).qb1 : (it_).qb0; const int b_ = (it_).bh >> 3, h_ = (it_).bh & 7; BlockRef<T, T> r_; \
        r_.Q = Qb + ((size_t)(it_).bh * SQ + (size_t)qb_ * QB) * D; r_.K = Kb + (size_t)(dry == 2 ? 0 : (it_).bh) * SKV * D; r_.V = Vb + (size_t)(dry == 2 ? 0 : (it_).bh) * SKV * D; \
        r_.O = YA + ((size_t)(b_ * SQ + qb_ * QB)) * OP + h_ * D; r_.C = Cb + (size_t)(it_).bh * SQ; r_.SSQ = psa + (size_t)h_ * M + b_ * SQ + qb_ * QB; r_.P0 = qb_ * QB; r_.dry = dry; r_; })
    SwaItem it = swa_decode(L, B, H, HKV, nqb, nx, nramp, order); int pass = 0;
    BlockRef<T, T> cur = MKREF(it, 0);
    Seam<T> S;
    causal_swa_prime<T, T>(cur, WINDOW, lds, S);
    for (;;) {
        const bool more_pass = pass == 0 && it.qb1 != it.qb0, more_item = L + stride < total, last = !more_pass && !more_item;
        SwaItem itn = it; int passn = pass + 1, Ln = L;
        if (!more_pass) { passn = 0; Ln = more_item ? L + stride : L; itn = swa_decode(Ln, B, H, HKV, nqb, nx, nramp, order); }
        const BlockRef<T, T> nxt = last ? cur : MKREF(itn, passn);
        causal_swa_block<T, T>(cur, nxt, SKV, WINDOW, lds, S);
        if (last) break;
        cur = nxt; it = itn; pass = passn; L = Ln;
    }
#undef MKREF
}

__global__ void __launch_bounds__(512, 2) fwd_mega(Params P) {
    extern __shared__ __attribute__((aligned(16))) unsigned char lds[];
    const int lo = P.lo, hi = P.hi;
    unsigned char* ws = P.ws;
    volatile LAS unsigned* xst = (volatile LAS unsigned*)((LAS unsigned char*)lds + (LDS_BYTES - 64));
    if (threadIdx.x < 2) xst[threadIdx.x] = 0u;
    __syncthreads();
    XcdBarrier xbar; xbar.bar = (unsigned*)(ws + WS_BAR); xbar.x = 0; xbar.st = xst;
    if (hi - lo > 1) xbar = xcd_barrier_post((unsigned*)(ws + WS_BAR), xst);
    if (lo < 0) cg::this_grid().sync();
    pg8::bf16_t* XN = (pg8::bf16_t*)(ws + WS_XN);
#ifndef PH_MASK
#define PH_MASK 31
#endif
#define IN(k) (((PH_MASK >> (k)) & 1) && lo <= (k) && (k) < hi)
#define SEAM(k) do { if (IN(k) && IN((k) + 1)) { xcd_barrier(xbar); } } while (0)
#ifndef PROBE_PHASE
#define PROBE_PHASE -1
#endif
    const float* psa = (const float*)(ws + WS_PSA); const float* psl = (const float*)(ws + WS_PSL); float* psm = (float*)(ws + WS_PSM); float* pse = (float*)(ws + WS_PSE); float* dummyf = (float*)(ws + WS_V);
    if (IN(0)) {
#pragma unroll 1
        for (int rp = (PROBE_PHASE == 0 ? 0 : 1); rp < 2; ++rp) { p0_phase(P, lds); __syncthreads(); } }
    SEAM(0);
    if (IN(1)) {
        cumsum_phase(P);
        static_assert(WS_K - WS_Q == 64 * MiB && WS_V - WS_K == 64 * MiB && WS_YA - WS_V == 64 * MiB && WS_XL - WS_YA == 64 * MiB && WS_YL - WS_XL == 64 * MiB, "region map");
#pragma unroll 1
        for (int rp = (PROBE_PHASE == 1 ? 0 : 1); rp < 2; ++rp) {
        pg8::Gemm g{XN, XN, (const pg8::bf16_t*)(ws + WS_W1), M, N1, DM, DM, DM / 64}; pg8::StaticOrder S; S.init(M, N1, gridDim.x, (int)blockIdx.x);
        pg8::EpiIn E{(pg8::bf16_t*)(ws + WS_Q)};
        pg8::gemm_phase<pg8::EpiIn, pg8::StaticOrder, true, true>((PG8_LAS unsigned char*)lds, g, S, E); }
    }
    SEAM(1);
    if (IN(2)) {
#pragma unroll 1
        for (int rp = (PROBE_PHASE == 2 ? 0 : 1); rp < 2; ++rp) lru_phase(P, lds, rp == 0);
#pragma unroll 1
        for (int rp = (PROBE_PHASE == 3 ? 0 : 1); rp < 2; ++rp) attn_phase(P, lds, rp == 0 ? 1 : 0);
    }
    SEAM(2);
    if (IN(3)) {
#pragma unroll 1
        for (int rp = (PROBE_PHASE == 4 ? 0 : 1); rp < 2; ++rp) {
        { pg8::Gemm g{(const pg8::bf16_t*)(ws + WS_PB), (const pg8::bf16_t*)(ws + WS_PB), (const pg8::bf16_t*)(ws + WS_WPLE), M, DM, DPLE, DPLE, DPLE / 64}; pg8::StaticOrder S; S.init(M, DM, gridDim.x, (int)blockIdx.x);
          pg8::EpiPle E{(pg8::bf16_t*)(ws + (rp ? WS_EP : WS_XL)), rp ? pse : dummyf};
          pg8::gemm_phase<pg8::EpiPle, pg8::StaticOrder, true, true>((PG8_LAS unsigned char*)lds, g, S, E); }
        { pg8::Gemm g{(const pg8::bf16_t*)(ws + WS_YA), (const pg8::bf16_t*)(ws + WS_YL), (const pg8::bf16_t*)(ws + WS_WOUT), M, DM, 2 * DM, DM, DM / 64}; pg8::StaticOrder S; S.init(M, DM, gridDim.x, (int)blockIdx.x);
          PG8_LAS float* scm = (PG8_LAS float*)((PG8_LAS unsigned char*)lds + 131072); PG8_LAS float* sce = scm + 2048;
          { pg8::Unit uu; for (int i = 0; i < 8 && S.next(i, uu); ++i) if (threadIdx.x < 256) { const int r = uu.pm * 256 + threadIdx.x; float sa = 0.f, sl = 0.f;
#pragma unroll
                for (int k = 0; k < 8; ++k) sa += psa[(size_t)k * M + r];
#pragma unroll
                for (int k = 0; k < 32; ++k) sl += psl[(size_t)k * M + r];
                const float ra = pg8::rstd_of(sa), rl = pg8::rstd_of(sl);
                scm[i * 256 + threadIdx.x] = ra / rl; sce[i * 256 + threadIdx.x] = rl; } }
          __syncthreads();
          pg8::EpiOut E{(pg8::bf16_t*)(ws + (rp ? WS_MIX : WS_XL)), scm, sce, rp ? psm : dummyf};
          pg8::gemm_phase<pg8::EpiOut, pg8::StaticOrder, true, true>((PG8_LAS unsigned char*)lds, g, S, E); } }
    }
    SEAM(3);
    if (IN(4)) {
#pragma unroll 1
        for (int rp = (PROBE_PHASE == 5 ? 0 : 1); rp < 2; ++rp) {
        pg8::Gemm g{XN, (const pg8::bf16_t*)(ws + WS_MIX), (const pg8::bf16_t*)(ws + WS_WG), M, DM, 2 * DM, DM, DM / 64}; pg8::StaticOrder S; S.init(M, DM, gridDim.x, (int)blockIdx.x);
        PG8_LAS float* scm = (PG8_LAS float*)((PG8_LAS unsigned char*)lds + 131072); PG8_LAS float* sce = scm + 2048; PG8_LAS float* scr = sce + 2048;
        { pg8::Unit uu; const float* rsxp = (const float*)(ws + WS_RSX);
          for (int i = 0; i < 8 && S.next(i, uu); ++i) if (threadIdx.x < 256) { const int r = uu.pm * 256 + threadIdx.x; float sm = 0.f, se = 0.f;
#pragma unroll
              for (int k = 0; k < 16; ++k) { sm += psm[(size_t)k * M + r]; se += pse[(size_t)k * M + r]; }
              const float rm = pg8::rstd_of(sm);
              scm[i * 256 + threadIdx.x] = rsxp[r] / rm; sce[i * 256 + threadIdx.x] = rm; scr[i * 256 + threadIdx.x] = pg8::rstd_of(se); } }
        __syncthreads();
        pg8::EpiFin E{P.in[0], scm, sce, scr, P.in[19], P.in[5], P.in[17],
                      (const pg8::bf16_t*)(ws + WS_MIX), (const pg8::bf16_t*)(ws + WS_EP), rp ? P.out : (float*)(ws + WS_V)};
        pg8::gemm_phase<pg8::EpiFin, pg8::StaticOrder, true, true>((PG8_LAS unsigned char*)lds, g, S, E); }
    }
#undef IN
#undef SEAM
}

#if PROBE_PHASE >= 10
__global__ void __launch_bounds__(512, 2) probe_kernel(Params P) {
    extern __shared__ __attribute__((aligned(16))) unsigned char lds[];
#if PROBE_PHASE == 10
    p0_phase(P, lds);
#elif PROBE_PHASE == 17
    attn_phase(P, lds, 2);
#elif PROBE_PHASE == 18
    attn_phase(P, lds, 1);
#elif PROBE_PHASE == 13
    attn_phase(P, lds, 0);
#elif PROBE_PHASE == 14
    { unsigned char* ws = P.ws; pg8::Gemm g{(const pg8::bf16_t*)(ws + WS_PB), (const pg8::bf16_t*)(ws + WS_PB), (const pg8::bf16_t*)(ws + WS_WPLE), M, DM, DPLE, DPLE, DPLE / 64}; pg8::StaticOrder S; S.init(M, DM, gridDim.x, (int)blockIdx.x);
      pg8::EpiPle E{(pg8::bf16_t*)(ws + WS_V), (float*)(ws + WS_XL)};
      pg8::gemm_phase<pg8::EpiPle, pg8::StaticOrder, true, true>((PG8_LAS unsigned char*)lds, g, S, E); }
#elif PROBE_PHASE == 15
    { unsigned char* ws = P.ws; const float* psa = (const float*)(ws + WS_PSA); const float* psl = (const float*)(ws + WS_PSL);
      pg8::Gemm g{(const pg8::bf16_t*)(ws + WS_YA), (const pg8::bf16_t*)(ws + WS_YL), (const pg8::bf16_t*)(ws + WS_WOUT), M, DM, 2 * DM, DM, DM / 64}; pg8::StaticOrder S; S.init(M, DM, gridDim.x, (int)blockIdx.x);
      PG8_LAS float* scm = (PG8_LAS float*)((PG8_LAS unsigned char*)lds + 131072); PG8_LAS float* sce = scm + 2048;
      { pg8::Unit uu; for (int i = 0; i < 8 && S.next(i, uu); ++i) if (threadIdx.x < 256) { const int r = uu.pm * 256 + threadIdx.x; float sa = 0.f, sl = 0.f; for (int k = 0; k < 8; ++k) sa += psa[(size_t)k * M + r]; for (int k = 0; k < 32; ++k) sl += psl[(size_t)k * M + r];
            const float ra = pg8::rstd_of(sa), rl = pg8::rstd_of(sl); scm[i * 256 + threadIdx.x] = ra / rl; sce[i * 256 + threadIdx.x] = rl; } }
      __syncthreads();
      pg8::EpiOut E{(pg8::bf16_t*)(ws + WS_XL), scm, sce, (float*)(ws + WS_V)};
      pg8::gemm_phase<pg8::EpiOut, pg8::StaticOrder, true, true>((PG8_LAS unsigned char*)lds, g, S, E); }
#endif
}
#endif
extern "C" void kernel_launch(void* const* d_in, const int* in_sizes, int n_in, void* d_out, int out_size, void* d_ws, size_t ws_size, hipStream_t stream) {
    static int grid = 0;
    if (grid == 0) {
        if (n_in != 20 || in_sizes[0] != M * DM || out_size != M * DM || ws_size < WS_END) { fprintf(stderr, "kernel_launch: shape mismatch (n_in %d, in0 %d, out %d, ws %zu)\n", n_in, n_in > 0 ? in_sizes[0] : -1, out_size, ws_size); grid = -1; return; }
        int dev = 0, cus = 0, per_cu = 0;
        (void)hipGetDevice(&dev); (void)hipDeviceGetAttribute(&cus, hipDeviceAttributeMultiprocessorCount, dev);
        if (hipFuncSetAttribute((const void*)fwd_mega, hipFuncAttributeMaxDynamicSharedMemorySize, LDS_BYTES) != hipSuccess) { fprintf(stderr, "kernel_launch: hipFuncSetAttribute failed\n"); grid = -1; return; }
        if (hipOccupancyMaxActiveBlocksPerMultiprocessor(&per_cu, (const void*)fwd_mega, 512, LDS_BYTES) != hipSuccess || per_cu < 1) { fprintf(stderr, "kernel_launch: occupancy query says %d\n", per_cu); per_cu = 1; }
        (void)hipGetLastError();
        grid = cus * per_cu; if (grid <= 0) grid = 256;
        if (grid < 64) { fprintf(stderr, "kernel_launch: grid %d < 64 workgroups: the per-workgroup row-scale tables hold at most 8 units\n", grid); grid = -1; return; }
    }
    if (grid < 0) return;
    Params p{};
    for (int i = 0; i < 20; ++i) p.in[i] = (const float*)d_in[i];
    p.out = (float*)d_out; p.ws = (unsigned char*)d_ws;
#if N_LAUNCHES == 1
    p.lo = 0; p.hi = 5;
    if (hipMemsetAsync((char*)d_ws + WS_BAR, 0, BAR_BYTES, stream) != hipSuccess) { fprintf(stderr, "kernel_launch: memset failed\n"); return; }
    void* args[] = {&p};
    hipError_t e = hipLaunchCooperativeKernel((const void*)fwd_mega, dim3(grid), dim3(512), args, LDS_BYTES, stream);
    if (e != hipSuccess) fprintf(stderr, "cooperative launch failed: %s (grid %d)\n", hipGetErrorString(e), grid);
#if PROBE_PHASE >= 10
    (void)hipFuncSetAttribute((const void*)probe_kernel, hipFuncAttributeMaxDynamicSharedMemorySize, LDS_BYTES);
    hipLaunchKernelGGL(probe_kernel, dim3(grid), dim3(512), LDS_BYTES, stream, p);
#endif
#else
    for (int ph = 0; ph < 5; ++ph) { p.lo = ph; p.hi = ph + 1; hipLaunchKernelGGL(fwd_mega, dim3(grid), dim3(512), LDS_BYTES, stream, p); }
#endif
}
```

```cpp
#include <hip/hip_runtime.h>
#include <hip/hip_bf16.h>
#include <hip/hip_cooperative_groups.h>
#include <cstdio>
#include <cstdint>
namespace cg = cooperative_groups;

#ifndef N_LAUNCHES
#define N_LAUNCHES 1
#endif

namespace pg8 {
#define PG8_LAS __attribute__((address_space(3)))
typedef unsigned short bf16_t;
typedef short bf16x8 __attribute__((ext_vector_type(8)));
typedef float f32x4 __attribute__((ext_vector_type(4)));
typedef unsigned u32x4 __attribute__((ext_vector_type(4)));
constexpr int BM = 256, BK = 64, HALF = 128, HTB = HALF * BK * 2  , STAGE_BYTES = 8 * HTB, NXCD = 8, WGM = 8;

__host__ __device__ __forceinline__ int lds_byte(int r, int c) { const int st = (r >> 4) * 2 + (c >> 5), rr = r & 15, cc = c & 31, ob = rr * 64 + cc * 2; return st * 1024 + (ob ^ (((ob >> 9) & 1) << 5)); }
__host__ __device__ __forceinline__ void stage_rc(int b, int& R, int& C) { const int st = b / 1024, sb = b % 1024, swz = sb ^ (((sb >> 9) & 1) << 5); R = (st >> 1) * 16 + swz / 64; C = (st & 1) * 32 + (swz % 64) / 2; }
__host__ __device__ __forceinline__ int perm32(int rho) { const int n = rho >> 4, i = rho & 15; return 8 * (i >> 2) + 4 * n + (i & 3); }

struct Unit { int pm, pn, ui; };
struct Gemm { const bf16_t* A; const bf16_t* A2; const bf16_t* Bt; int M, N, K, lda, nt0; };

struct StaticOrder {
    int nM, nN, nwg, G, c;
    __host__ __device__ void init(int M, int N, int G_, int c_) { nM = M / BM; nN = N / BM; nwg = nM * nN; G = G_; c = c_; }
    __host__ __device__ bool next(int i, Unit& u) const {
        const long L = (long)i * G + c; if (L >= nwg) return false;
        int wgid = (int)L; { const int q = nwg / NXCD, r = nwg % NXCD, xcd = wgid % NXCD, off = wgid / NXCD; wgid = (xcd < r ? xcd * (q + 1) : r * (q + 1) + (xcd - r) * q) + off; }
        const int nig = WGM * nN, gid = wgid / nig, fm = gid * WGM, gsz = (nM - fm) < WGM ? (nM - fm) : WGM;
        u.pm = fm + ((wgid % nig) % gsz); u.pn = (wgid % nig) / gsz; u.ui = i; return true;
    }
    __device__ __forceinline__ void a_ready(const Unit&) const {}
    __device__ __forceinline__ void done(const Unit&) const {}
};
__device__ __forceinline__ unsigned cvt_pk_bf16(float lo, float hi) { unsigned r; asm volatile("v_cvt_pk_bf16_f32 %0, %1, %2" : "=v"(r) : "v"(lo), "v"(hi)); return r; }
typedef _Float16 h16x2_t __attribute__((ext_vector_type(2)));
__device__ __forceinline__ unsigned cvt_pk_f16(float lo, float hi) { const h16x2_t v = {(_Float16)lo, (_Float16)hi}; return __builtin_bit_cast(unsigned, v); }
__device__ __forceinline__ float h_lo(unsigned w) { return (float)__builtin_bit_cast(h16x2_t, w)[0]; }
__device__ __forceinline__ float h_hi(unsigned w) { return (float)__builtin_bit_cast(h16x2_t, w)[1]; }
__device__ __forceinline__ float sigm_f(float x) { return __builtin_amdgcn_rcpf(1.0f + __expf(-x)); }
__device__ __forceinline__ float silu_f(float x) { return x * sigm_f(x); }
__device__ __forceinline__ float bf_lo(unsigned w) { return __uint_as_float(w << 16); }
__device__ __forceinline__ float bf_hi(unsigned w) { return __uint_as_float(w & 0xffff0000u); }
constexpr float RMS_EPS = 1e-6f;
__device__ __forceinline__ float rstd_of(float ssq) { return 1.0f / sqrtf(ssq * (1.0f / 1024.0f) + RMS_EPS); }

struct EpiIn {
    static constexpr bool PERM = true, MID = false, AFTER_DRAIN = false, PREF = false;
    bf16_t* R0;
    __device__ __forceinline__ void mid(f32x4 (&)[2][2][4][2], const Unit&, int, int) const {}
    __device__ __forceinline__ void operator()(const f32x4 (&acc)[2][2][4][2], const Unit& u, int wr, int wc, int fr, int fq) const {
        const int region = u.pn >> 2, cr0 = (u.pn & 3) * 256 + wc * 32 + 8 * fq, row0 = u.pm * BM + wr * 64 + fr;
        if (region < 3) {
            bf16_t* base = R0 + (size_t)region * (32u << 20);
            const int b = row0 >> 12;
#pragma unroll
            for (int ai = 0; ai < 2; ++ai)
#pragma unroll
                for (int m = 0; m < 4; ++m) { const int s = (row0 + ai * HALF + m * 16) & 4095;
#pragma unroll
                    for (int bj = 0; bj < 2; ++bj) { const int c = cr0 + bj * HALF, head = c >> 7, d = c & 127;
                        const f32x4 v0 = acc[ai][bj][m][0], v1 = acc[ai][bj][m][1]; u32x4 w;
                        w.x = cvt_pk_bf16(v0[0], v0[1]); w.y = cvt_pk_bf16(v0[2], v0[3]); w.z = cvt_pk_bf16(v1[0], v1[1]); w.w = cvt_pk_bf16(v1[2], v1[3]);
                        *(u32x4*)(base + ((size_t)((b * 8 + head) * 4096 + s)) * 128 + d) = w; } }
        } else {
            bf16_t* base = R0 + (size_t)region * (32u << 20); const bool act = region != 4;
#pragma unroll
            for (int ai = 0; ai < 2; ++ai)
#pragma unroll
                for (int m = 0; m < 4; ++m) { bf16_t* rowp = base + (size_t)(row0 + ai * HALF + m * 16) * 1024 + cr0;
#pragma unroll
                    for (int bj = 0; bj < 2; ++bj) { f32x4 v0 = acc[ai][bj][m][0], v1 = acc[ai][bj][m][1];
                        if (act) { v0 = (f32x4){silu_f(v0[0]), silu_f(v0[1]), silu_f(v0[2]), silu_f(v0[3])}; v1 = (f32x4){silu_f(v1[0]), silu_f(v1[1]), silu_f(v1[2]), silu_f(v1[3])}; }
                        u32x4 w;
                        if (act) { w.x = cvt_pk_bf16(v0[0], v0[1]); w.y = cvt_pk_bf16(v0[2], v0[3]); w.z = cvt_pk_bf16(v1[0], v1[1]); w.w = cvt_pk_bf16(v1[2], v1[3]); }
                        else { w.x = cvt_pk_f16(v0[0], v0[1]); w.y = cvt_pk_f16(v0[2], v0[3]); w.z = cvt_pk_f16(v1[0], v1[1]); w.w = cvt_pk_f16(v1[2], v1[3]); }
                        *(u32x4*)(rowp + bj * HALF) = w; } }
        }
    }
};
struct EpiPle {
    static constexpr bool PERM = true, MID = false, AFTER_DRAIN = false, PREF = false;
    bf16_t* EP; float* ssq;
    __device__ __forceinline__ void mid(f32x4 (&)[2][2][4][2], const Unit&, int, int) const {}
    __device__ __forceinline__ void operator()(const f32x4 (&acc)[2][2][4][2], const Unit& u, int wr, int wc, int fr, int fq) const {
        const int col0 = u.pn * BM + wc * 32 + 8 * fq, row0 = u.pm * BM + wr * 64 + fr;
#pragma unroll
        for (int ai = 0; ai < 2; ++ai)
#pragma unroll
            for (int m = 0; m < 4; ++m) { const int r = row0 + ai * HALF + m * 16; float s2 = 0.f;
#pragma unroll
                for (int bj = 0; bj < 2; ++bj) { const f32x4 v0 = acc[ai][bj][m][0], v1 = acc[ai][bj][m][1];
                    s2 += (v0[0] * v0[0] + v0[1] * v0[1]) + (v0[2] * v0[2] + v0[3] * v0[3]) + (v1[0] * v1[0] + v1[1] * v1[1]) + (v1[2] * v1[2] + v1[3] * v1[3]);
                    u32x4 w; w.x = cvt_pk_bf16(v0[0], v0[1]); w.y = cvt_pk_bf16(v0[2], v0[3]); w.z = cvt_pk_bf16(v1[0], v1[1]); w.w = cvt_pk_bf16(v1[2], v1[3]);
                    *(u32x4*)(EP + (size_t)r * 1024 + col0 + bj * HALF) = w; }
                s2 += __shfl_xor(s2, 16); s2 += __shfl_xor(s2, 32);
                if (fq == 0) ssq[(size_t)(u.pn * 4 + wc) * 32768 + r] = s2; }
    }
};
struct EpiOut {
    static constexpr bool PERM = true, MID = true, AFTER_DRAIN = false, PREF = false;
    bf16_t* MIX; const PG8_LAS float* scm; const PG8_LAS float* sce; float* ssq_m;
    __device__ __forceinline__ void mid(f32x4 (&acc)[2][2][4][2], const Unit& u, int wr, int fr) const {
#pragma unroll
        for (int ai = 0; ai < 2; ++ai)
#pragma unroll
            for (int m = 0; m < 4; ++m) { const int r = u.pm * BM + ai * HALF + wr * 64 + m * 16 + fr;
                const float s = scm[u.ui * 256 + ai * HALF + wr * 64 + m * 16 + fr]; (void)r;
#pragma unroll
                for (int bj = 0; bj < 2; ++bj) { acc[ai][bj][m][0] *= s; acc[ai][bj][m][1] *= s; } }
    }
    __device__ __forceinline__ void operator()(const f32x4 (&acc)[2][2][4][2], const Unit& u, int wr, int wc, int fr, int fq) const {
        const int col0 = u.pn * BM + wc * 32 + 8 * fq, row0 = u.pm * BM + wr * 64 + fr;
        float rl8[2][4];
#pragma unroll
        for (int ai = 0; ai < 2; ++ai)
#pragma unroll
            for (int m = 0; m < 4; ++m) rl8[ai][m] = sce[u.ui * 256 + ai * HALF + wr * 64 + m * 16 + fr];
#pragma unroll
        for (int ai = 0; ai < 2; ++ai)
#pragma unroll
            for (int m = 0; m < 4; ++m) rl8[ai][m] = rl8[ai][m];
#pragma unroll
        for (int ai = 0; ai < 2; ++ai)
#pragma unroll
            for (int m = 0; m < 4; ++m) { const int r = row0 + ai * HALF + m * 16; float s2 = 0.f; const float rl = rl8[ai][m];
#pragma unroll
                for (int bj = 0; bj < 2; ++bj) { const f32x4 v0 = acc[ai][bj][m][0] * rl, v1 = acc[ai][bj][m][1] * rl;
                    s2 += (v0[0] * v0[0] + v0[1] * v0[1]) + (v0[2] * v0[2] + v0[3] * v0[3]) + (v1[0] * v1[0] + v1[1] * v1[1]) + (v1[2] * v1[2] + v1[3] * v1[3]);
                    u32x4 w; w.x = cvt_pk_bf16(v0[0], v0[1]); w.y = cvt_pk_bf16(v0[2], v0[3]); w.z = cvt_pk_bf16(v1[0], v1[1]); w.w = cvt_pk_bf16(v1[2], v1[3]);
                    *(u32x4*)(MIX + (size_t)r * 1024 + col0 + bj * HALF) = w; }
                s2 += __shfl_xor(s2, 16); s2 += __shfl_xor(s2, 32);
                if (fq == 0) ssq_m[(size_t)(u.pn * 4 + wc) * 32768 + r] = s2; }
    }
};
struct EpiFin {
    static constexpr bool PERM = true, MID = true, AFTER_DRAIN = false, PREF = false;
    __device__ __forceinline__ void pref(const Unit& u, int tid) const {
        const char* base = (const char*)(x + (size_t)(u.pm * BM) * 1024 + u.pn * BM);
        unsigned sink = 0u;
#pragma unroll
        for (int k = 0; k < 4; ++k) { const int line = tid + 512 * k; sink += *(const unsigned*)(base + (size_t)(line >> 3) * 4096 + (line & 7) * 128); }
        asm volatile("" :: "v"(sink));
    }
    const float* x; const PG8_LAS float* scm; const PG8_LAS float* sce; const PG8_LAS float* scr; const float* bg; const float* postg; const float* pleg;
    const bf16_t* MIX; const bf16_t* EP; float* out;
    __device__ __forceinline__ void mid(f32x4 (&acc)[2][2][4][2], const Unit& u, int wr, int fr) const {
#pragma unroll
        for (int ai = 0; ai < 2; ++ai)
#pragma unroll
            for (int m = 0; m < 4; ++m) { const int r = u.pm * BM + ai * HALF + wr * 64 + m * 16 + fr;
                const float s = scm[u.ui * 256 + ai * HALF + wr * 64 + m * 16 + fr]; (void)r;
#pragma unroll
                for (int bj = 0; bj < 2; ++bj) { acc[ai][bj][m][0] *= s; acc[ai][bj][m][1] *= s; } }
    }
    __device__ __forceinline__ void operator()(const f32x4 (&acc)[2][2][4][2], const Unit& u, int wr, int wc, int fr, int fq) const {
        const int col0 = u.pn * BM + wc * 32 + 8 * fq, row0 = u.pm * BM + wr * 64 + fr;
#pragma unroll
        for (int bj = 0; bj < 2; ++bj) { const int c = col0 + bj * HALF;
            const f32x4 b0 = *(const f32x4*)(bg + c), b1 = *(const f32x4*)(bg + c + 4), g0 = *(const f32x4*)(postg + c), g1 = *(const f32x4*)(postg + c + 4),
                        e0 = *(const f32x4*)(pleg + c), e1 = *(const f32x4*)(pleg + c + 4);
#pragma unroll
            for (int am = 0; am < 4; ++am) { const int ai = am >> 1, mb = (am & 1) * 2;
                f32x4 x0[2], x1[2]; u32x4 mw[2], ew[2];
#pragma unroll
                for (int k = 0; k < 2; ++k) { const int r = row0 + ai * HALF + (mb + k) * 16; const size_t off = (size_t)r * 1024 + c;
                    x0[k] = *(const f32x4*)(x + off); x1[k] = *(const f32x4*)(x + off + 4); mw[k] = *(const u32x4*)(MIX + off); ew[k] = *(const u32x4*)(EP + off); }
#pragma unroll
                for (int k = 0; k < 2; ++k) { const int m = mb + k; const int r = row0 + ai * HALF + m * 16; const size_t off = (size_t)r * 1024 + c;
                    const float rm = sce[u.ui * 256 + (r - u.pm * BM)], re = scr[u.ui * 256 + (r - u.pm * BM)];
                    const f32x4 a0 = acc[ai][bj][m][0] * rm + b0, a1 = acc[ai][bj][m][1] * rm + b1;
                    const f32x4 m0 = (f32x4){bf_lo(mw[k].x), bf_hi(mw[k].x), bf_lo(mw[k].y), bf_hi(mw[k].y)}, m1 = (f32x4){bf_lo(mw[k].z), bf_hi(mw[k].z), bf_lo(mw[k].w), bf_hi(mw[k].w)};
                    const f32x4 q0 = (f32x4){bf_lo(ew[k].x), bf_hi(ew[k].x), bf_lo(ew[k].y), bf_hi(ew[k].y)}, q1 = (f32x4){bf_lo(ew[k].z), bf_hi(ew[k].z), bf_lo(ew[k].w), bf_hi(ew[k].w)};
                    f32x4 o0, o1;
#pragma unroll
                    for (int j = 0; j < 4; ++j) { o0[j] = x0[k][j] + m0[j] * rm * g0[j] + sigm_f(a0[j]) * (q0[j] * re * e0[j]); o1[j] = x1[k][j] + m1[j] * rm * g1[j] + sigm_f(a1[j]) * (q1[j] * re * e1[j]); }
                    *(f32x4*)(out + off) = o0; *(f32x4*)(out + off + 4) = o1; } } }
    }
};
template <class Epi, class Sched, bool ALIGN_EPI = false, bool SP2 = false>
__device__ __forceinline__ void gemm_phase(PG8_LAS unsigned char* lds, const Gemm g, const Sched& S, const Epi& E) {
    int tid_ = threadIdx.x; asm volatile("" : "+v"(tid_));
    const int tid = tid_, wid = __builtin_amdgcn_readfirstlane(tid >> 6), lane = tid & 63, wr = wid >> 2, wc = wid & 3, fr = lane & 15, fq = lane >> 4;
    const int K = g.K, nt = K / BK;
    unsigned voffA[2], voffB[2];
#pragma unroll
    for (int i = 0; i < 2; ++i) { int R, C; stage_rc(tid * 16 + i * 8192, R, C); const int Rb = Epi::PERM ? ((R & ~31) + perm32(R & 31)) : R;
        voffA[i] = (unsigned)(R * g.lda + C) * 2u; voffB[i] = (unsigned)(Rb * K + C) * 2u; }
    const size_t kstep = (size_t)(BK * 2);
    const size_t hstep = (size_t)HALF * K * 2, tstep = 2 * hstep;
    const size_t hstepA = (size_t)HALF * g.lda * 2, tstepA = 2 * hstepA; const int nt0 = g.nt0;
#define PG8_APTR(c0, c1, tt) ((tt) < nt0 ? (c0) + (size_t)(tt) * kstep : (c1) + (size_t)((tt) - nt0) * kstep)
    const unsigned ldsw = (unsigned)wid * 1024u;
    const int aoff = lds_byte(wr * 64 + fr, fq * 8), boff = lds_byte(wc * 32 + fr, fq * 8);
#define PG8_SA(b, h) (((b) * 2 + (h)) * HTB)
#define PG8_SB(b, h) ((4 + (b) * 2 + (h)) * HTB)
#define PG8_STAGE(bufoff, gbase, voff) do { _Pragma("unroll") for (int _i = 0; _i < 2; ++_i) \
        __builtin_amdgcn_global_load_lds((const unsigned*)((const char*)(gbase) + (voff)[_i]), (PG8_LAS unsigned*)(lds + (bufoff) + ldsw + _i * 8192), 16, 0, 0); } while (0)
#define PG8_LDA(dst, b, h) do { _Pragma("unroll") for (int m = 0; m < 4; ++m) _Pragma("unroll") for (int k = 0; k < 2; ++k) dst[m][k] = *(const PG8_LAS bf16x8*)(lds + PG8_SA(b, h) + aoff + m * 2048 + k * 1024); } while (0)
#define PG8_LDB(dst, b, h) do { _Pragma("unroll") for (int n = 0; n < 2; ++n) _Pragma("unroll") for (int k = 0; k < 2; ++k) dst[n][k] = *(const PG8_LAS bf16x8*)(lds + PG8_SB(b, h) + boff + n * 2048 + k * 1024); } while (0)
#define PG8_MMA(ai, bj, At, Bt) do { __builtin_amdgcn_s_setprio(1); _Pragma("unroll") for (int m = 0; m < 4; ++m) _Pragma("unroll") for (int n = 0; n < 2; ++n) _Pragma("unroll") for (int k = 0; k < 2; ++k) \
        acc[ai][bj][m][n] = __builtin_amdgcn_mfma_f32_16x16x32_bf16(Bt[n][k], At[m][k], acc[ai][bj][m][n], 0, 0, 0); __builtin_amdgcn_s_setprio(0); } while (0)
#define PG8_WAIT_V(n) asm volatile("s_waitcnt vmcnt(" #n ")" ::: "memory")
#define PG8_WAIT_L(n) asm volatile("s_waitcnt lgkmcnt(" #n ")" ::: "memory")
#define PG8_BAR __builtin_amdgcn_s_barrier()
#define PG8_SCHED __builtin_amdgcn_sched_barrier(0)
    Unit cur, nxt; int ui = 0;
    if (!S.next(0, cur)) return;
    f32x4 acc[2][2][4][2];
#pragma unroll
    for (int a = 0; a < 2; ++a)
#pragma unroll
        for (int b = 0; b < 2; ++b)
#pragma unroll
            for (int m = 0; m < 4; ++m)
#pragma unroll
                for (int n = 0; n < 2; ++n) acc[a][b][m][n] = (f32x4){0.f, 0.f, 0.f, 0.f};
    bf16x8 At[4][2], B0[2][2], B1[2][2];
    const char* cA = (const char*)g.A + (size_t)cur.pm * tstepA; const char* cA2 = (const char*)g.A2 + (size_t)cur.pm * tstepA; const char* cB = (const char*)g.Bt + (size_t)cur.pn * tstep;
    S.a_ready(cur);
    if constexpr (SP2) {
        PG8_STAGE(PG8_SB(0, 0), cB, voffB); PG8_STAGE(PG8_SB(0, 1), cB + hstep, voffB); PG8_STAGE(PG8_SA(0, 0), cA, voffA); PG8_STAGE(PG8_SA(0, 1), cA + hstepA, voffA);
        if (wr == 1) PG8_BAR;
        PG8_WAIT_V(2); PG8_BAR;
        PG8_STAGE(PG8_SB(1, 0), cB + kstep, voffB); PG8_STAGE(PG8_SA(1, 0), cA + kstep, voffA); PG8_STAGE(PG8_SB(1, 1), cB + hstep + kstep, voffB);
        PG8_WAIT_V(6); PG8_BAR;
    } else {
        PG8_STAGE(PG8_SB(0, 0), cB, voffB); PG8_STAGE(PG8_SA(0, 0), cA, voffA); PG8_STAGE(PG8_SB(0, 1), cB + hstep, voffB); PG8_STAGE(PG8_SA(0, 1), cA + hstepA, voffA);
        if (wr == 1) PG8_BAR;
        PG8_WAIT_V(4); PG8_BAR;
        PG8_STAGE(PG8_SB(1, 0), cB + kstep, voffB); PG8_STAGE(PG8_SA(1, 0), cA + kstep, voffA); PG8_STAGE(PG8_SB(1, 1), cB + hstep + kstep, voffB);
        PG8_WAIT_V(6); PG8_BAR;
    }
    if constexpr (Epi::PREF) { int tp_ = threadIdx.x; asm volatile("" : "+v"(tp_)); E.pref(cur, tp_); }
    for (;;) {
        const bool has_next = S.next(ui + 1, nxt);
        const char* nA = has_next ? (const char*)g.A + (size_t)nxt.pm * tstepA : cA; const char* nA2 = has_next ? (const char*)g.A2 + (size_t)nxt.pm * tstepA : cA2; const char* nB = has_next ? (const char*)g.Bt + (size_t)nxt.pn * tstep : cB;
        for (int t = 0; t < nt; t += 2) {
            const bool last = (t == nt - 2);
            if constexpr (Epi::MID) { if (t == nt0) E.mid(acc, cur, wr, fr); }
            const char* a1 = PG8_APTR(cA, cA2, t + 1);
            const char* a2 = last ? nA : PG8_APTR(cA, cA2, t + 2); const char* b2 = last ? nB : cB + (size_t)(t + 2) * kstep;
            const char* a3 = a2 + kstep; const char* b3 = b2 + kstep;
            if (last && has_next) S.a_ready(nxt);
            if constexpr (SP2) {
            PG8_LDB(B0, 0, 0); PG8_LDB(B1, 0, 1); PG8_SCHED; PG8_LDA(At, 0, 0); PG8_STAGE(PG8_SA(1, 1), a1 + hstepA, voffA);
            PG8_WAIT_V(8); PG8_WAIT_L(0); PG8_BAR; PG8_MMA(0, 0, At, B0); PG8_MMA(0, 1, At, B1); PG8_BAR; PG8_SCHED;
            PG8_LDA(At, 0, 1); PG8_STAGE(PG8_SB(0, 0), b2, voffB); PG8_STAGE(PG8_SB(0, 1), b2 + hstep, voffB); PG8_STAGE(PG8_SA(0, 0), a2, voffA);
            PG8_WAIT_V(8); PG8_WAIT_L(0); PG8_BAR; PG8_MMA(1, 0, At, B0); PG8_MMA(1, 1, At, B1); PG8_BAR; PG8_SCHED;
            PG8_LDB(B0, 1, 0); PG8_LDB(B1, 1, 1); PG8_SCHED; PG8_LDA(At, 1, 0); PG8_STAGE(PG8_SA(0, 1), a2 + hstepA, voffA);
            PG8_WAIT_V(8); PG8_WAIT_L(0); PG8_BAR; PG8_MMA(0, 0, At, B0); PG8_MMA(0, 1, At, B1); PG8_BAR; PG8_SCHED;
            PG8_LDA(At, 1, 1); PG8_STAGE(PG8_SB(1, 0), b3, voffB); PG8_STAGE(PG8_SB(1, 1), b3 + hstep, voffB); PG8_STAGE(PG8_SA(1, 0), a3, voffA);
            PG8_WAIT_V(8); PG8_WAIT_L(0); PG8_BAR; PG8_MMA(1, 0, At, B0); PG8_MMA(1, 1, At, B1); PG8_BAR; PG8_SCHED;
            } else {
            PG8_LDB(B0, 0, 0); PG8_SCHED; PG8_LDA(At, 0, 0); PG8_STAGE(PG8_SA(1, 1), a1 + hstepA, voffA);
            PG8_WAIT_L(8); PG8_BAR; PG8_WAIT_L(0); PG8_MMA(0, 0, At, B0); PG8_BAR; PG8_SCHED;
            PG8_LDB(B1, 0, 1); PG8_STAGE(PG8_SB(0, 0), b2, voffB);
            PG8_BAR; PG8_WAIT_L(0); PG8_MMA(0, 1, At, B1); PG8_BAR;
            PG8_LDA(At, 0, 1); PG8_STAGE(PG8_SA(0, 0), a2, voffA);
            PG8_BAR; PG8_WAIT_L(0); PG8_MMA(1, 0, At, B0); PG8_BAR; PG8_SCHED;
            PG8_STAGE(PG8_SB(0, 1), b2 + hstep, voffB);
            PG8_WAIT_V(6); PG8_BAR; PG8_MMA(1, 1, At, B1); PG8_BAR;
            PG8_LDB(B0, 1, 0); PG8_SCHED; PG8_LDA(At, 1, 0); PG8_STAGE(PG8_SA(0, 1), a2 + hstepA, voffA);
            PG8_WAIT_L(8); PG8_BAR; PG8_WAIT_L(0); PG8_MMA(0, 0, At, B0); PG8_BAR; PG8_SCHED;
            PG8_LDB(B1, 1, 1); PG8_STAGE(PG8_SB(1, 0), b3, voffB);
            PG8_BAR; PG8_WAIT_L(0); PG8_MMA(0, 1, At, B1); PG8_BAR;
            PG8_LDA(At, 1, 1); PG8_STAGE(PG8_SA(1, 0), a3, voffA);
            PG8_BAR; PG8_WAIT_L(0); PG8_MMA(1, 0, At, B0); PG8_BAR; PG8_SCHED;
            PG8_STAGE(PG8_SB(1, 1), b3 + hstep, voffB);
            PG8_WAIT_V(6); PG8_BAR; PG8_MMA(1, 1, At, B1); PG8_BAR;
            }
        }
        if constexpr (ALIGN_EPI) { if (wr == 0) PG8_BAR; }
        if constexpr (!Epi::AFTER_DRAIN) { E(acc, cur, wr, wc, fr, fq); S.done(cur); }
        if (!has_next) break;
#pragma unroll
        for (int a = 0; a < 2; ++a)
#pragma unroll
            for (int b = 0; b < 2; ++b)
#pragma unroll
                for (int m = 0; m < 4; ++m)
#pragma unroll
                    for (int n = 0; n < 2; ++n) acc[a][b][m][n] = (f32x4){0.f, 0.f, 0.f, 0.f};
        cur = nxt; cA = nA; cA2 = nA2; cB = nB; ++ui;
        if constexpr (Epi::PREF) { int tp_ = threadIdx.x; asm volatile("" : "+v"(tp_)); E.pref(cur, tp_); }
        if constexpr (ALIGN_EPI) { if (wr == 1) PG8_BAR; }
    }
    PG8_WAIT_V(0);
    if constexpr (!ALIGN_EPI) { if (wr == 0) PG8_BAR; }
    PG8_BAR;
#undef PG8_SA
#undef PG8_APTR
#undef PG8_SB
#undef PG8_STAGE
#undef PG8_LDA
#undef PG8_LDB
#undef PG8_MMA
#undef PG8_WAIT_V
#undef PG8_WAIT_L
#undef PG8_BAR
#undef PG8_SCHED
}}

namespace att {
enum { ORDER_NATURAL = 0, ORDER_REVERSED = 1, ORDER_PAIRED = 2, ORDER_XCD = 4 };
constexpr int B = 8, H = 8, HKV = 8, SQ = 4096, SKV = 4096, D = 128;
constexpr int QOFF = 0, WINDOW = SKV;
constexpr float THR = 8.f;
constexpr bool WSKIP = false;
constexpr int OP = 1024;
constexpr int SSQ_STG_OFF = 83968;
constexpr int BIAS_OFF = 67584;
constexpr float SCALE = 0.08838834764831845f;
constexpr int NW = 8, QBLK = 32, KVBLK = 64, QB = NW * QBLK;
constexpr int SHM_V = KVBLK * D * 2, SHM_K = KVBLK * D * 2;
constexpr int LDS_BYTES = 2 * SHM_V + 2 * SHM_K + NW * 64 * 4;
static_assert(D == 128 && SQ % QB == 0 && SKV % KVBLK == 0 && H % HKV == 0 && QOFF >= 0 && QOFF + SQ <= SKV && WINDOW >= 1, "geometry");

using bf16 = __hip_bfloat16;
typedef short bf16x8 __attribute__((ext_vector_type(8)));
typedef short s16x4 __attribute__((ext_vector_type(4)));
typedef float f32x16 __attribute__((ext_vector_type(16)));
typedef float f32x4 __attribute__((ext_vector_type(4)));
typedef unsigned u32x4 __attribute__((ext_vector_type(4)));
template <class A, class Bt> struct same_t { static constexpr bool v = false; };
template <class A> struct same_t<A, A> { static constexpr bool v = true; };

#define KSWZ(row, colB) ((row) * 256 + ((colB) ^ (((row) & 7) << 4)))
#define SBAR() __builtin_amdgcn_sched_barrier(0)
__device__ __forceinline__ int v_st(int k, int c) { const int kk = (k & ~0xC) | ((k & 4) << 1) | ((k & 8) >> 1); return ((kk >> 3) * 4 + (c >> 5)) * 512 + ((kk & 7) * 32 + (c & 31)) * 2; }
__device__ __forceinline__ int v_rd_base(int lane) { return ((lane & 3) << 3) | (((lane >> 2) & 3) << 6) | (((lane >> 4) & 1) << 5) | (((lane >> 5) & 1) << 8); }
constexpr int v_rd_off(int d0, int ks, int half) { return d0 * 512 + ks * 4096 + half * 2048; }
__device__ __forceinline__ int crow(int r, int hi) { return (r & 3) + 8 * (r >> 2) + 4 * hi; }
__device__ __forceinline__ unsigned cvtpk(float lo, float hi) {
    unsigned r; asm volatile("v_cvt_pk_bf16_f32 %0, %1, %2" : "=v"(r) : "v"(lo), "v"(hi)); return r;
}
__device__ __forceinline__ bf16x8 pack8(f32x4 a, f32x4 b) {
    u32x4 w = {cvtpk(a[0], a[1]), cvtpk(a[2], a[3]), cvtpk(b[0], b[1]), cvtpk(b[2], b[3])};
    return *reinterpret_cast<bf16x8*>(&w);
}
template <class T> __device__ __forceinline__ bf16x8 load8(const T* p) {
    if constexpr (same_t<T, float>::v) { return pack8(*(const f32x4*)p, *(const f32x4*)(p + 4)); }
    else { return *reinterpret_cast<const bf16x8*>(p); }
}
__device__ __forceinline__ void mask_tile(f32x16& p0, f32x16& p1, int dq, unsigned W) {
    const float NEG = -__builtin_inff();
#pragma unroll
    for (int r = 0; r < 16; ++r) {
        const int c = (r & 3) + 8 * (r >> 2);
        if ((unsigned)(dq - c) >= W) p0[r] = NEG;
        if ((unsigned)(dq - c - 32) >= W) p1[r] = NEG;
    }
}
__device__ __forceinline__ void partialSM(f32x16& p0, f32x16& p1, float& m_reg, float& mn, float& alpha) {
    float pmax = p0[0]; for (int r = 1; r < 16; ++r) pmax = fmaxf(pmax, p0[r]); for (int r = 0; r < 16; ++r) pmax = fmaxf(pmax, p1[r]);
    { auto rr = __builtin_amdgcn_permlane32_swap(__float_as_uint(pmax), __float_as_uint(pmax), false, false);
      pmax = fmaxf(__uint_as_float(rr[0]), __uint_as_float(rr[1])); }
    constexpr float C2 = 1.4426950408889634f * SCALE;
    if (__builtin_expect(__all((pmax - m_reg) * SCALE <= THR), 1)) { mn = m_reg; alpha = 1.f; }
    else { mn = fmaxf(m_reg, pmax); alpha = __builtin_amdgcn_exp2f((m_reg - mn) * C2); m_reg = mn; }
    const float mnL = -mn * C2;
    for (int r = 0; r < 16; ++r) p0[r] = fmaf(p0[r], C2, mnL); for (int r = 0; r < 16; ++r) p1[r] = fmaf(p1[r], C2, mnL);
    for (int r = 0; r < 16; ++r) p0[r] = __builtin_amdgcn_exp2f(p0[r]);
}
__device__ __forceinline__ void finishSM(f32x16& p0, f32x16& p1, float alpha, float& l_reg, bf16x8& pa0, bf16x8& pa1, bf16x8& pa2, bf16x8& pa3) {
    for (int r = 0; r < 16; ++r) p1[r] = __builtin_amdgcn_exp2f(p1[r]);
    float ps = 0; for (int r = 0; r < 16; ++r) ps += p0[r]; for (int r = 0; r < 16; ++r) ps += p1[r];
    { auto rr = __builtin_amdgcn_permlane32_swap(__float_as_uint(ps), __float_as_uint(ps), false, false);
      ps = __uint_as_float(rr[0]) + __uint_as_float(rr[1]); }
    l_reg = l_reg * alpha + ps;
#define PK4(P, B_, OUT) do { unsigned a0 = cvtpk(P[B_+0], P[B_+1]), a1 = cvtpk(P[B_+2], P[B_+3]);                          \
        unsigned b0 = cvtpk(P[B_+4], P[B_+5]), b1 = cvtpk(P[B_+6], P[B_+7]);                                             \
        auto r0 = __builtin_amdgcn_permlane32_swap(a0, b0, false, false); auto r1 = __builtin_amdgcn_permlane32_swap(a1, b1, false, false); \
        u32x4 w = {r0[0], r1[0], r0[1], r1[1]}; OUT = *reinterpret_cast<bf16x8*>(&w); } while (0)
    PK4(p0, 0, pa0); PK4(p0, 8, pa1); PK4(p1, 0, pa2); PK4(p1, 8, pa3);
#undef PK4
}
template <int KB, bool SK>
__device__ __forceinline__ void qkt(f32x16& p0, f32x16& p1, const char* K_lds, int r32, int hi, const bf16x8* qr, bool act) {
    if (SK && !act) { const float NEG = -__builtin_inff();
#pragma unroll
        for (int r = 0; r < 16; ++r) { p0[r] = NEG; p1[r] = NEG; } return; }
    const char* kb[4];
#pragma unroll
    for (int dd = 0; dd < 4; ++dd) kb[dd] = K_lds + KB * SHM_K + KSWZ(r32, (dd * 16 + hi * 8) * 2);
#pragma unroll
    for (int d0 = 0; d0 < 8; ++d0) { const char* a = kb[d0 & 3] + (d0 >> 2) * 128;
        bf16x8 b0 = *reinterpret_cast<const bf16x8*>(a);
        bf16x8 b1 = *reinterpret_cast<const bf16x8*>(a + 32 * 256);
        p0 = __builtin_amdgcn_mfma_f32_32x32x16_bf16(b0, qr[d0], p0, 0, 0, 0);
        p1 = __builtin_amdgcn_mfma_f32_32x32x16_bf16(b1, qr[d0], p1, 0, 0, 0); }
}
template <int VB, bool SK>
__device__ __forceinline__ void pv_tile(f32x16* o, int vb0, bf16x8 pa0, bf16x8 pa1, bf16x8 pa2, bf16x8 pa3, bool act) {
    if (SK && !act) return;
#define TRRD(dst, off) asm volatile("ds_read_b64_tr_b16 %0, %1 offset:%2" : "=&v"(dst) : "v"(vb0), "i"(off) : "memory")
#define PV_D0(d0) do { s16x4 l0, l1, l2, l3, h0, h1, h2, h3; constexpr int b_ = VB * SHM_V + v_rd_off(d0, 0, 0);     \
        TRRD(l0, b_); TRRD(h0, b_ + 2048); TRRD(l1, b_ + 4096); TRRD(h1, b_ + 6144); TRRD(l2, b_ + 8192); TRRD(h2, b_ + 10240); TRRD(l3, b_ + 12288); TRRD(h3, b_ + 14336); \
        asm volatile("s_waitcnt lgkmcnt(0)" ::: "memory"); SBAR();                 \
        o[d0] = __builtin_amdgcn_mfma_f32_32x32x16_bf16(pa0, (bf16x8){l0[0], l0[1], l0[2], l0[3], h0[0], h0[1], h0[2], h0[3]}, o[d0], 0, 0, 0);   \
        o[d0] = __builtin_amdgcn_mfma_f32_32x32x16_bf16(pa1, (bf16x8){l1[0], l1[1], l1[2], l1[3], h1[0], h1[1], h1[2], h1[3]}, o[d0], 0, 0, 0);   \
        o[d0] = __builtin_amdgcn_mfma_f32_32x32x16_bf16(pa2, (bf16x8){l2[0], l2[1], l2[2], l2[3], h2[0], h2[1], h2[2], h2[3]}, o[d0], 0, 0, 0);   \
        o[d0] = __builtin_amdgcn_mfma_f32_32x32x16_bf16(pa3, (bf16x8){l3[0], l3[1], l3[2], l3[3], h3[0], h3[1], h3[2], h3[3]}, o[d0], 0, 0, 0); } while (0)
    PV_D0(0); PV_D0(1); PV_D0(2); PV_D0(3);
#undef PV_D0
#undef TRRD
}
template <class TIn, class TOut> struct BlockRef { const TIn* Q; const TIn* K; const TIn* V; TOut* O; const float* C; float* SSQ; int P0; int dry; };
template <class TIn> struct Seam {
    bf16x8 qr[8];
    bf16x8 st_v0, st_v1, st_k0, st_k1; f32x4 sf0, sf1, sf2, sf3;
    f32x4 tq[16];
};
__device__ __forceinline__ int swa_jlo(int P0, int W) { const int lowk = P0 - W + 1; return lowk > 0 ? lowk / KVBLK : 0; }
#define ROW(p, k0, rr) ((p) + (size_t)((k0) + (rr)) * D + sc)
#define VMW() asm volatile("s_waitcnt vmcnt(0)" ::: "memory")
#define VMWN(n) asm volatile("s_waitcnt vmcnt(%0)" :: "i"(n) : "memory")
#define SLOAD_H(Kp, Vp, k0) do { S.st_v0 = load8<TIn>(ROW(Vp, k0, sr)); S.st_v1 = load8<TIn>(ROW(Vp, k0, 32 + sr));              \
                         S.st_k0 = load8<TIn>(ROW(Kp, k0, sr)); S.st_k1 = load8<TIn>(ROW(Kp, k0, 32 + sr)); } while (0)
#define SWRITE_HK(bf) do { *(bf16x8*)(K_lds + (bf) * SHM_K + kws) = S.st_k0; *(bf16x8*)(K_lds + (bf) * SHM_K + kws + 32 * 256) = S.st_k1; } while (0)
#define SWRITE_HV(bf) do { *(bf16x8*)(V_lds + (bf) * SHM_V + vst0) = S.st_v0; *(bf16x8*)(V_lds + (bf) * SHM_V + vst1) = S.st_v1; } while (0)
#define SWRITE_H(bf) do { SWRITE_HV(bf); SWRITE_HK(bf); } while (0)
#define SLOAD_F(p, k0) do { S.sf0 = *(const f32x4*)ROW(p, k0, sr); S.sf1 = *(const f32x4*)(ROW(p, k0, sr) + 4);                \
                            S.sf2 = *(const f32x4*)ROW(p, k0, 32 + sr); S.sf3 = *(const f32x4*)(ROW(p, k0, 32 + sr) + 4); } while (0)
#define SWRITE_KF(bf) do { *(bf16x8*)(K_lds + (bf) * SHM_K + kws) = pack8(S.sf0, S.sf1); *(bf16x8*)(K_lds + (bf) * SHM_K + kws + 32 * 256) = pack8(S.sf2, S.sf3); } while (0)
#define SWRITE_VF(bf) do { *(bf16x8*)(V_lds + (bf) * SHM_V + vst0) = pack8(S.sf0, S.sf1); *(bf16x8*)(V_lds + (bf) * SHM_V + vst1) = pack8(S.sf2, S.sf3); } while (0)
template <class TIn, class TOut>
__device__ __forceinline__ void causal_swa_prime(const BlockRef<TIn, TOut>& cur, int W, char* lds, Seam<TIn>& S) {
    constexpr bool F32 = same_t<TIn, float>::v;
    int tid_l = threadIdx.x; asm volatile("" : "+v"(tid_l));
    const int tid = tid_l, wid = __builtin_amdgcn_readfirstlane(tid >> 6), lane = tid & 63, r32 = lane & 31, hi = lane >> 5;
    const int sr = tid >> 4, sc = (tid & 15) * 8, kws = KSWZ(sr, sc * 2); char* K_lds = lds + 2 * SHM_V;
    const int kb0 = ((cur.P0 + QB - 1) / KVBLK) * KVBLK; (void)W;
    for (int d0 = 0; d0 < 8; ++d0) S.qr[d0] = load8<TIn>(cur.Q + (size_t)(wid * QBLK + r32) * D + d0 * 16 + hi * 8);
    if constexpr (F32) { SLOAD_F((const float*)cur.K, kb0); VMW(); SWRITE_KF(0); SBAR(); SLOAD_F((const float*)cur.V, kb0); }
    else { SLOAD_H(cur.K, cur.V, kb0); VMW(); SWRITE_HK(0); }
    __syncthreads();
}
template <class TIn, class TOut>
__device__ __forceinline__ void causal_swa_block(const BlockRef<TIn, TOut>& cur, const BlockRef<TIn, TOut>& nxt, int skv, int W, char* lds, Seam<TIn>& S) {
    constexpr bool F32 = same_t<TIn, float>::v;
    int tid_l = threadIdx.x; asm volatile("" : "+v"(tid_l));
    const int tid = tid_l, wid = __builtin_amdgcn_readfirstlane(tid >> 6), lane = tid & 63, r32 = lane & 31, hi = lane >> 5;
    const int j_lo = swa_jlo(cur.P0, W);
    int j_hi = (cur.P0 + QB - 1) / KVBLK + 1; if (j_hi > skv / KVBLK) j_hi = skv / KVBLK;
    const int NT = j_hi - j_lo;
    const int kbn = ((nxt.P0 + QB - 1) / KVBLK) * KVBLK;
    const int qlo = cur.P0 + wid * QBLK, qm = qlo + r32 - 4 * hi;
    char* V_lds = lds; char* K_lds = lds + 2 * SHM_V;
    float* ws = (float*)(lds + 2 * SHM_V + 2 * SHM_K) + wid * 64; float* li_l = ws, * al_l = ws + 32;
    float m_reg = -1e30f, l_reg = 0; f32x16 o[4] = {};
    const int sr = tid >> 4, sc = (tid & 15) * 8, vst0 = v_st(sr, sc), vst1 = v_st(32 + sr, sc), kws = KSWZ(sr, sc * 2);
    const int vb0 = (int)(uintptr_t)V_lds + v_rd_base(lane);
    const TIn* Kh = cur.K; const TIn* Vh = cur.V;
#define RESC(a) do { if (__any((a) < 1.f)) { if (hi == 0) al_l[r32] = (a); asm volatile("s_waitcnt lgkmcnt(0)" ::: "memory");              \
                     for (int d_ = 0; d_ < 4; ++d_) for (int r = 0; r < 16; ++r) o[d_][r] *= al_l[crow(r, hi)]; } } while (0)
#define KBASE(t) ((j_hi - 1 - (t)) * KVBLK)
#define ACT(t) (KBASE(t) <= qlo + QBLK - 1 && KBASE(t) + KVBLK - 1 >= qlo - W + 1)
#define MASKT(P0_, P1_, t) do { const int kb_ = KBASE(t); if ((!SK || ACT(t)) && (kb_ + KVBLK - 1 > qlo || kb_ <= qlo + QBLK - 1 - W)) mask_tile(P0_, P1_, qm - kb_, (unsigned)W); } while (0)
    constexpr int NQL = F32 ? 16 : 8;
    constexpr bool SK = WSKIP && !F32;
#define SEAM_K0() do { VMWN(NQL + 16); if constexpr (F32) { SWRITE_KF(0); SBAR(); SLOAD_F((const float*)nxt.V, kbn); } else { SWRITE_HK(0); } SBAR(); } while (0)
    f32x16 pA0, pA1, pB0, pB1; float mnA, mnB, alA, alB; bf16x8 pa0, pa1, pa2, pa3;
    int hz = hi; asm volatile("" : "+v"(hz));
#define LOADB(P0_, P1_, t) do { const char* bp_ = (const char*)cur.C + (unsigned)((KBASE(t) + 4 * hz) * 4);                                    \
        _Pragma("unroll") for (int j_ = 0; j_ < 4; ++j_) { const f32x4 b0_ = *(const f32x4*)(bp_ + 32 * j_), b1_ = *(const f32x4*)(bp_ + 128 + 32 * j_); \
            P0_[4*j_] = b0_[0]; P0_[4*j_+1] = b0_[1]; P0_[4*j_+2] = b0_[2]; P0_[4*j_+3] = b0_[3]; P1_[4*j_] = b1_[0]; P1_[4*j_+1] = b1_[1]; P1_[4*j_+2] = b1_[2]; P1_[4*j_+3] = b1_[3]; } } while (0)
    LOADB(pA0, pA1, 0); if (NT > 1) LOADB(pB0, pB1, 1);
    if constexpr (F32) { VMW(); SWRITE_VF(0); SBAR(); } else { SWRITE_HV(0); SBAR(); }
    if (NT > 1) { if constexpr (F32) SLOAD_F((const float*)Kh, KBASE(1)); else SLOAD_H(Kh, Vh, KBASE(1)); }
    SBAR(); qkt<0, SK>(pA0, pA1, K_lds, r32, hi, S.qr, ACT(0));
    if constexpr (F32) { if (NT > 1) { VMW(); SWRITE_KF(1); SBAR(); SLOAD_F((const float*)Vh, KBASE(1)); } }
    MASKT(pA0, pA1, 0); partialSM(pA0, pA1, m_reg, mnA, alA);
    if (NT > 1) { VMW(); if constexpr (F32) { SWRITE_VF(1); SBAR(); if (NT > 2) SLOAD_F((const float*)Kh, KBASE(2)); } else SWRITE_H(1); }
    __syncthreads();
#define HALF_STEP(PX0, PX1, mnX, alX, PY0, PY1, alY, t, KB, VB, SB) do {                                                      \
        SBAR(); qkt<KB, SK>(PX0, PX1, K_lds, r32, hi, S.qr, ACT(t));                                             \
        finishSM(PY0, PY1, alY, l_reg, pa0, pa1, pa2, pa3); SBAR();                                                           \
        if ((t) + 1 < NT) { LOADB(PY0, PY1, (t) + 1); SBAR(); }                                                               \
        if ((t) + 1 < NT) { if constexpr (F32) { VMW(); SWRITE_KF(SB); SBAR(); SLOAD_F((const float*)Vh, KBASE((t) + 1)); }  \
                            else { SLOAD_H(Kh, Vh, KBASE((t) + 1)); } SBAR(); }                                               \
        pv_tile<VB, SK>(o, vb0, pa0, pa1, pa2, pa3, ACT((t) - 1)); MASKT(PX0, PX1, (t)); partialSM(PX0, PX1, m_reg, mnX, alX);                                        \
        __syncthreads();                                                                                                      \
        if ((t) + 1 < NT) { VMW(); if constexpr (F32) { SWRITE_VF(SB); SBAR(); if ((t) + 2 < NT) SLOAD_F((const float*)Kh, KBASE((t) + 2)); } \
                            else { SWRITE_H(SB); } }                                                                          \
        RESC(alX); __syncthreads(); } while (0)
    for (int t = 1; t + 1 < NT; t += 2) {
        HALF_STEP(pB0, pB1, mnB, alB, pA0, pA1, alA, t, 1, 0, 0);
        HALF_STEP(pA0, pA1, mnA, alA, pB0, pB1, alB, t + 1, 0, 1, 1);
    }
    const bool even = (NT & 1) == 0;
    if (even) { SBAR(); qkt<1, SK>(pB0, pB1, K_lds, r32, hi, S.qr, ACT(NT - 1)); SBAR(); }
#define QROW(e) (nxt.Q + (size_t)(wid * QBLK + r32) * D + ((e) >> 1) * 16 + hi * 8 + ((e) & 1) * 4)
    if constexpr (F32) { SLOAD_F((const float*)nxt.K, kbn); SBAR();
#pragma unroll
        for (int e = 0; e < 8; ++e) S.tq[e] = *(const f32x4*)QROW(e); }
    else { SLOAD_H(nxt.K, nxt.V, kbn); SBAR();
#pragma unroll
        for (int d0 = 0; d0 < 8; ++d0) S.qr[d0] = load8<TIn>(nxt.Q + (size_t)(wid * QBLK + r32) * D + d0 * 16 + hi * 8); }
    SBAR();
    finishSM(pA0, pA1, alA, l_reg, pa0, pa1, pa2, pa3); SBAR();
    if constexpr (F32) {
#pragma unroll
        for (int e = 8; e < 16; ++e) S.tq[e] = *(const f32x4*)QROW(e); SBAR(); }
#undef QROW
    pv_tile<0, SK>(o, vb0, pa0, pa1, pa2, pa3, ACT(even ? NT - 2 : NT - 1));
    typedef unsigned u32x2_t __attribute__((ext_vector_type(2)));
    u32x2_t gv[4][4];
    int lz = lane; asm volatile("" : "+v"(lz));
    char* Obw = (char*)cur.O + (size_t)(wid * QBLK) * OP * 2;
#define GLOAD() do { _Pragma("unroll") for (int d0_ = 0; d0_ < 4; ++d0_) _Pragma("unroll") for (int j_ = 0; j_ < 4; ++j_) { const int chunk_ = 64 * j_ + lz; \
        gv[d0_][j_] = *(const u32x2_t*)(Obw + (unsigned)(((chunk_ >> 3) * OP + d0_ * 32 + (chunk_ & 7) * 4) * 2)); } } while (0)
    if (even) { MASKT(pB0, pB1, NT - 1); partialSM(pB0, pB1, m_reg, mnB, alB); __syncthreads(); RESC(alB);
        finishSM(pB0, pB1, alB, l_reg, pa0, pa1, pa2, pa3); SBAR(); GLOAD(); SBAR(); pv_tile<1, SK>(o, vb0, pa0, pa1, pa2, pa3, ACT(NT - 1)); }
    else { SBAR(); GLOAD(); }
    SBAR(); SEAM_K0();
    if (hi == 0) li_l[r32] = l_reg; asm volatile("s_waitcnt lgkmcnt(0)" ::: "memory");
    float rli[16];
#pragma unroll
    for (int r = 0; r < 16; ++r) rli[r] = __builtin_amdgcn_rcpf(li_l[crow(r, hi)]);
    const int rz = lz & 31, hq = lz >> 5;
    float* ost = (float*)(lds + SSQ_STG_OFF) + wid * 1024;
    float* sqp = cur.SSQ + wid * QBLK;
    float s2r[4] = {0.f, 0.f, 0.f, 0.f};
#if PROBE_PHASE == 3 || PROBE_PHASE == 13
    if (!cur.dry)
#endif
#pragma unroll
    for (int d0 = 0; d0 < 4; ++d0) {
#pragma unroll
        for (int r = 0; r < 16; ++r) ost[(4 * hq + (r & 3) + 8 * (r >> 2)) * 32 + rz] = o[d0][r] * rli[r];
        asm volatile("s_waitcnt lgkmcnt(0)" ::: "memory");
#pragma unroll
        for (int j = 0; j < 4; ++j) { const int chunk = 64 * j + lz; const f32x4 vv = *(const f32x4*)(ost + chunk * 4);
            s2r[j] += (vv[0] * vv[0] + vv[1] * vv[1]) + (vv[2] * vv[2] + vv[3] * vv[3]);
            const unsigned g0 = gv[d0][j][0], g1 = gv[d0][j][1]; u32x2_t w;
            w[0] = cvtpk(vv[0] * __uint_as_float(g0 << 16), vv[1] * __uint_as_float(g0 & 0xffff0000u)); w[1] = cvtpk(vv[2] * __uint_as_float(g1 << 16), vv[3] * __uint_as_float(g1 & 0xffff0000u));
            *(u32x2_t*)(Obw + (unsigned)(((chunk >> 3) * OP + d0 * 32 + (chunk & 7) * 4) * 2)) = w; }
        asm volatile("s_waitcnt lgkmcnt(0)" ::: "memory");
    }
#pragma unroll
    for (int j = 0; j < 4; ++j) { float t = s2r[j]; t += __shfl_xor(t, 1); t += __shfl_xor(t, 2); t += __shfl_xor(t, 4);
#if PROBE_PHASE == 3 || PROBE_PHASE == 13
        if ((lz & 7) == 0 && !cur.dry) sqp[8 * j + (lz >> 3)] = t; }
#else
        if ((lz & 7) == 0) sqp[8 * j + (lz >> 3)] = t; }
#endif
    if constexpr (F32) {
#pragma unroll
        for (int d0 = 0; d0 < 8; ++d0) S.qr[d0] = pack8(S.tq[2 * d0], S.tq[2 * d0 + 1]); }
    __syncthreads();
#undef RESC
#undef LOADB
#undef GLOAD
#undef KBASE
#undef ACT
#undef MASKT
#undef SEAM_K0
#undef HALF_STEP
}
#undef ROW
#undef VMW
#undef VMWN
#undef SLOAD_H
#undef SWRITE_HK
#undef SWRITE_HV
#undef SWRITE_H
#undef SLOAD_F
#undef SWRITE_KF
#undef SWRITE_VF

__host__ __device__ inline int swa_nramp(int nqb, int W, int qoff) { const int t = W - 1 - qoff; const int n = t < 0 ? 0 : t / QB + 1; return n > nqb ? nqb : n; }
__host__ __device__ inline int swa_nx(int nqb, int nramp, int order) { return (order & ORDER_PAIRED) ? (nramp + 1) / 2 + (nqb - nramp) : nqb; }
struct SwaItem { int bh, qb0, qb1; };
__device__ __forceinline__ SwaItem swa_decode(int L, int nb, int nh, int nhkv, int nqb, int nx, int nramp, int order) {
    const int G = nh / nhkv; SwaItem it; int x;
    if ((order & ORDER_XCD) && (nb * nhkv) % 8 == 0) { const int xcd = L & 7, k = L >> 3, per = G * nx, gi = k / per, r = k - gi * per;
        it.bh = (gi * 8 + xcd) * G + r / nx; x = r % nx; }
    else { it.bh = L / nx; x = L - it.bh * nx; }
    if (order & ORDER_PAIRED) { const int ns = nqb - nramp;
        if (x < ns) { it.qb0 = it.qb1 = nqb - 1 - x; } else { it.qb0 = x - ns; it.qb1 = nramp - 1 - it.qb0; } }
    else { it.qb0 = it.qb1 = ((order & 3) == ORDER_REVERSED) ? nqb - 1 - x : x; }
    return it;
}}

#define LAS __attribute__((address_space(3)))
typedef unsigned short bf16u;
typedef float f32x4 __attribute__((ext_vector_type(4)));
typedef unsigned v4u __attribute__((ext_vector_type(4)));
typedef unsigned v2u __attribute__((ext_vector_type(2)));
typedef short bf16x8 __attribute__((ext_vector_type(8)));
typedef float f32x16 __attribute__((ext_vector_type(16)));
#define LDS_WAIT() asm volatile("s_waitcnt lgkmcnt(0)" ::: "memory")
#define XB_TMO      128
#define XB_XCNT(j)  (256  + 64 * (j))
#define XB_XSUB(j)  (1280 + 64 * (j))
#define XB_XGEN(j)  (2304 + 64 * (j))
#define XB_TOP      3328
#define XB_TOPGEN   3392
#define XCD_BAR_WORDS 3456
#define XB_SPIN_CAP (1u << 18)

__device__ __forceinline__ unsigned xb_ld(unsigned* p)              { return __hip_atomic_load(p, __ATOMIC_RELAXED, __HIP_MEMORY_SCOPE_AGENT); }
__device__ __forceinline__ unsigned xb_add(unsigned* p, unsigned v) { return __hip_atomic_fetch_add(p, v, __ATOMIC_RELAXED, __HIP_MEMORY_SCOPE_AGENT); }
__device__ __forceinline__ unsigned xb_xcc_id() { return (unsigned)__builtin_amdgcn_s_getreg((3 << 11) | 20) & 0xFu; }
#define XB_SPIN(cond, bar) do { unsigned _sp = 0; while (cond) { __builtin_amdgcn_s_sleep(1); \
    if ((++_sp & 255u) == 0u) { if (xb_ld(&(bar)[XB_TMO])) break; if (_sp > XB_SPIN_CAP) { atomicAdd(&(bar)[XB_TMO], 1u); break; } } } } while (0)

struct XcdBarrier {
    unsigned* bar; unsigned x;
    volatile LAS unsigned* st;
};

__device__ __forceinline__ XcdBarrier xcd_barrier_post(unsigned* bar, volatile LAS unsigned* st) {
    XcdBarrier b; b.bar = bar; b.x = xb_xcc_id(); b.st = st;
    if (threadIdx.x == 0) (void)xb_add(&bar[XB_XCNT(b.x)], 1u);
    return b;
}
__device__ __forceinline__ void xcd_barrier_complete(unsigned* bar, unsigned x, unsigned& nloc, unsigned& nx) {
    const unsigned G = gridDim.x * gridDim.y * gridDim.z;
    unsigned sum, cnt, mine, sp = 0u;
    for (;;) {
        sum = 0u; cnt = 0u; mine = 0u;
#pragma unroll
        for (unsigned j = 0; j < 16; ++j) { const unsigned c = xb_ld(&bar[XB_XCNT(j)]); sum += c; cnt += (c > 0u) ? 1u : 0u; mine = (j == x) ? c : mine; }
        if (sum == G) break;
        __builtin_amdgcn_s_sleep(1);
        if ((++sp & 255u) == 0u) { if (xb_ld(&bar[XB_TMO])) break; if (sp > XB_SPIN_CAP) { atomicAdd(&bar[XB_TMO], 1u); break; } }
    }
    nloc = mine > 0u ? mine : 1u; nx = cnt > 0u ? cnt : 1u;
}

__device__ __forceinline__ void xcd_barrier(const XcdBarrier& b) {
    asm volatile("s_waitcnt vmcnt(0)" ::: "memory");
    __syncthreads();
    if (threadIdx.x == 0) {
        unsigned* bar = b.bar;
        __builtin_amdgcn_s_waitcnt(0);
        unsigned nloc = b.st[0], nx = b.st[1];
        if (nloc == 0u) { xcd_barrier_complete(bar, b.x, nloc, nx); b.st[0] = nloc; b.st[1] = nx; }
        const unsigned old = xb_add(&bar[XB_XSUB(b.x)], 1u);
        const unsigned gen = old / nloc;
        if (old + 1u == (gen + 1u) * nloc) {
            __builtin_amdgcn_fence(__ATOMIC_RELEASE, "agent");
            asm volatile("s_waitcnt vmcnt(0)" ::: "memory");
            const unsigned og = xb_add(&bar[XB_TOP], 1u);
            const unsigned tg = og / nx;
            if (og + 1u == (tg + 1u) * nx) xb_add(&bar[XB_TOPGEN], 1u);
            else XB_SPIN(xb_ld(&bar[XB_TOPGEN]) == tg, bar);
            __builtin_amdgcn_fence(__ATOMIC_ACQUIRE, "agent");
            xb_add(&bar[XB_XGEN(b.x)], 1u);
            asm volatile("s_waitcnt vmcnt(0)" ::: "memory");
        } else {
            XB_SPIN(xb_ld(&bar[XB_XGEN(b.x)]) == gen, bar);
            __builtin_amdgcn_fence(__ATOMIC_ACQUIRE, "agent");
            asm volatile("s_waitcnt vmcnt(0)" ::: "memory");
        }
    }
    __syncthreads();
}

constexpr int M = 32768, DM = 1024, SEQ = 4096, NB = 8, NH = 8, DIN = 6152, N1 = 6144, DPLE = 256;
constexpr size_t MiB = 1u << 20;
constexpr size_t WS_SSQ = 0;
constexpr size_t WS_PSA = 488 * MiB;
constexpr size_t WS_PSL = 489 * MiB;
constexpr size_t WS_PSM = 493 * MiB;
constexpr size_t WS_PSE = 495 * MiB;
constexpr size_t WS_RSX = 512 * 1024;
constexpr size_t WS_BAR = 640 * 1024, BAR_BYTES = 16384;
constexpr size_t WS_LS = 1 * MiB;
constexpr size_t WS_C = 2 * MiB;
constexpr size_t WS_WRT = 3 * MiB, WS_WIT = 3 * MiB + 256 * 1024, WS_WPLE = 3 * MiB + 512 * 1024;
constexpr size_t WS_W1 = 4 * MiB, WS_WOUT = 16 * MiB, WS_WG = 20 * MiB, WS_PB = 24 * MiB, WS_XN = 40 * MiB;
constexpr size_t WS_Q = 104 * MiB, WS_K = 168 * MiB, WS_V = 232 * MiB, WS_YA = 296 * MiB, WS_XL = 360 * MiB, WS_YL = 424 * MiB, WS_END = 497 * MiB;
constexpr size_t WS_EP = WS_Q, WS_MIX = WS_K;
constexpr int LDS_BYTES = 163840;

struct Params { const float* in[20]; float* out; unsigned char* ws; int lo, hi; };

__device__ __forceinline__ float wave_sum(float v) {
#pragma unroll
    for (int o = 1; o < 64; o <<= 1) v += __shfl_xor(v, o);
    return v;
}
__device__ __forceinline__ unsigned pk2(float lo, float hi) { return pg8::cvt_pk_bf16(lo, hi); }
typedef _Float16 h16x8 __attribute__((ext_vector_type(8)));
__device__ __forceinline__ unsigned pkh2(float lo, float hi) { return pg8::cvt_pk_f16(lo, hi); }

__device__ __forceinline__ void tr_item(const float* W, int ldw, int nblk, bf16u* WT, int Kt, int koff, int row_off, const float* ksc, bool recip, LAS float* scr, int item, int lane, bool f16out = false) {
    const int kb = item / nblk, nb = item % nblk, k0 = 64 * kb, n0 = 32 * nb;
    float wv[32];
#pragma unroll
    for (int i = 0; i < 32; ++i) wv[i] = W[(size_t)(k0 + 2 * i + (lane >> 5)) * ldw + n0 + (lane & 31)];
    if (ksc) { float sv[32];
#pragma unroll
        for (int i = 0; i < 32; ++i) sv[i] = ksc[k0 + 2 * i + (lane >> 5)];
#pragma unroll
        for (int i = 0; i < 32; ++i) wv[i] *= recip ? 1.0f / sv[i] : sv[i]; }
#pragma unroll
    for (int i = 0; i < 32; ++i) scr[(2 * i + (lane >> 5)) * 33 + (lane & 31)] = wv[i];
    LDS_WAIT(); asm volatile("" ::: "memory");
    const int c = lane & 7;
#pragma unroll
    for (int j = 0; j < 4; ++j) { const int n = (lane >> 3) + 8 * j; const LAS float* s = scr + (8 * c) * 33 + n;
        v4u o; if (f16out) { o.x = pkh2(s[0 * 33], s[1 * 33]); o.y = pkh2(s[2 * 33], s[3 * 33]); o.z = pkh2(s[4 * 33], s[5 * 33]); o.w = pkh2(s[6 * 33], s[7 * 33]); }
        else { o.x = pk2(s[0 * 33], s[1 * 33]); o.y = pk2(s[2 * 33], s[3 * 33]); o.z = pk2(s[4 * 33], s[5 * 33]); o.w = pk2(s[6 * 33], s[7 * 33]); }
        *(v4u*)(WT + (size_t)(row_off + n0 + n) * Kt + koff + k0 + 8 * c) = o; }
    LDS_WAIT(); asm volatile("" ::: "memory");
}

__device__ __forceinline__ void p0_phase(const Params& P, unsigned char* lds) {
    int tid_l = threadIdx.x; asm volatile("" : "+v"(tid_l));
    const int tid = tid_l, lane = tid & 63, wid = __builtin_amdgcn_readfirstlane(tid >> 6), G = gridDim.x;
    unsigned char* ws = P.ws;
    LAS float* scr = (LAS float*)((LAS unsigned char*)lds + wid * 8448);
    LAS float* wfl = (LAS float*)((LAS unsigned char*)lds + 67584);
    const float* w_in = P.in[2];
    { float wt[16];
#pragma unroll
      for (int j = 0; j < 16; ++j) { const int i = tid + 512 * j; wt[j] = w_in[(size_t)(i >> 3) * DIN + 3072 + (i & 7)]; }
#pragma unroll
      for (int j = 0; j < 16; ++j) { const int i = tid + 512 * j; wfl[(i & 7) * 1024 + (i >> 3)] = wt[j]; } }
    const int gid = blockIdx.x * 512 + tid, NT = G * 512;
    const int gw = blockIdx.x * 8 + wid, NGW = G * 8;
    bf16u* W1t = (bf16u*)(ws + WS_W1); bf16u* Wot = (bf16u*)(ws + WS_WOUT); bf16u* Wgt = (bf16u*)(ws + WS_WG); bf16u* Wpt = (bf16u*)(ws + WS_WPLE);
    bf16u* WrT = (bf16u*)(ws + WS_WRT); bf16u* WiT = (bf16u*)(ws + WS_WIT);
    for (int it = gw; it < 5376; it += NGW) {
        int r = it; const float* W; int ldw, nblk, Kt, koff = 0, row_off = 0, item; bf16u* WT; const float* ksc = nullptr; bool recip = false, f16o = false;
        if (r < 3072) { const int hf = r >= 1536; item = r - hf * 1536; W = w_in + hf * 3080; ldw = DIN; nblk = 96; WT = W1t; Kt = 1024; row_off = hf * 3072; }
        else if ((r -= 3072) < 1024) { const int hf = r >= 512; item = r - hf * 512; W = P.in[15] + (size_t)hf * 1024 * 1024; ldw = 1024; nblk = 32; WT = Wot; Kt = 2048; koff = hf * 1024; ksc = hf ? P.in[14] : P.in[13]; }
        else if ((r -= 1024) < 1024) { const int hf = r >= 512; item = r - hf * 512; W = P.in[18]; ldw = 1024; nblk = 32; WT = Wgt; Kt = 2048; koff = hf * 1024; ksc = hf ? P.in[5] : P.in[4]; recip = !hf; }
        else if ((r -= 1024) < 128) { item = r; W = P.in[16]; ldw = 1024; nblk = 32; WT = Wpt; Kt = 256; }
        else { r -= 128; const int gi = r >= 64; r -= gi * 64; item = r & 7; W = (gi ? P.in[10] : P.in[8]) + (r >> 3) * 16384; ldw = 128; nblk = 4; WT = gi ? WiT : WrT; Kt = 128; row_off = (r >> 3) * 128; f16o = true; }
        tr_item(W, ldw, nblk, WT, Kt, koff, row_off, ksc, recip, scr, item, lane, f16o);
    }
    { const f32x4* p4 = (const f32x4*)P.in[1]; v4u* o = (v4u*)(ws + WS_PB);
      for (int i = gid; i < M * DPLE / 8; i += 4 * NT) { f32x4 a[4], b[4];
#pragma unroll
          for (int k = 0; k < 4; ++k) { const int ii = i + k * NT; const int jj = ii < M * DPLE / 8 ? ii : i; a[k] = p4[2 * jj]; b[k] = p4[2 * jj + 1]; }
#pragma unroll
          for (int k = 0; k < 4; ++k) { const int ii = i + k * NT; if (ii < M * DPLE / 8) { v4u w; w.x = pk2(a[k][0], a[k][1]); w.y = pk2(a[k][2], a[k][3]); w.z = pk2(b[k][0], b[k][1]); w.w = pk2(b[k][2], b[k][3]); o[ii] = w; } } } }
    __syncthreads();
    const float* x = P.in[0]; bf16u* XN = (bf16u*)(ws + WS_XN); float* RSX = (float*)(ws + WS_RSX); float* LS = (float*)(ws + WS_LS);
    f32x4 pg[4];
#pragma unroll
    for (int j = 0; j < 4; ++j) pg[j] = *((const f32x4*)P.in[4] + lane + 64 * j);
    const float bfl = lane < 8 ? P.in[3][lane] : 0.f;
    for (int m0 = gw; m0 < M; m0 += 4 * NGW) {
        f32x4 vr[4][4];
#pragma unroll
        for (int rr = 0; rr < 4; ++rr) { const int mm = m0 + rr * NGW; const f32x4* xa = (const f32x4*)(x + (size_t)(mm < M ? mm : m0) * DM) + lane;
#pragma unroll
            for (int j = 0; j < 4; ++j) vr[rr][j] = xa[64 * j]; }
#pragma unroll
        for (int rr = 0; rr < 4; ++rr) {
            const int m = m0 + rr * NGW; if (m >= M) break;
            f32x4 v[4]; float ss = 0.f;
#pragma unroll
            for (int j = 0; j < 4; ++j) { v[j] = vr[rr][j]; ss += (v[j][0] * v[j][0] + v[j][1] * v[j][1]) + (v[j][2] * v[j][2] + v[j][3] * v[j][3]); }
            ss = wave_sum(ss);
            const float var = ss * (1.0f / DM) + 1e-6f, rstd = 1.0f / sqrtf(var);
            v2u* o8 = (v2u*)(XN + (size_t)m * DM) + lane;
#pragma unroll
            for (int j = 0; j < 4; ++j) { v[j] = v[j] * rstd * pg[j]; v2u w; w.x = pk2(v[j][0], v[j][1]); w.y = pk2(v[j][2], v[j][3]); o8[64 * j] = w; }
            float f[8];
#pragma unroll
            for (int h = 0; h < 8; ++h) { float a = 0.f;
#pragma unroll
                for (int j = 0; j < 4; ++j) { const f32x4 w = *(const LAS f32x4*)(wfl + h * 1024 + 256 * j + 4 * lane); a += (v[j][0] * w[0] + v[j][1] * w[1]) + (v[j][2] * w[2] + v[j][3] * w[3]); }
                f[h] = wave_sum(a); }
            float z = f[0];
#pragma unroll
            for (int h = 1; h < 8; ++h) z = (lane == h) ? f[h] : z;
            z += bfl;
            const float ls = fminf(z, 0.f) - log1pf(__expf(-fabsf(z)));
            if (lane < 8) LS[(size_t)(((m >> 12) * 8 + lane)) * SEQ + (m & 4095)] = ls;
            if (lane == 8) RSX[m] = sqrtf(var);
        }
    }
}

__device__ __forceinline__ void cumsum_phase(const Params& P, unsigned char* lds_g) {
    int tid_l = threadIdx.x; asm volatile("" : "+v"(tid_l));
    const int tid = tid_l, lane = tid & 63, wid = tid >> 6;
    const float* LS = (const float*)(P.ws + WS_LS); float* C = (float*)(P.ws + WS_C);
    LAS double* wtot = (LAS double*)((LAS unsigned char*)lds_g);
    for (int bh = blockIdx.x; bh < 64; bh += gridDim.x) {
        const f32x4* src = (const f32x4*)(LS + (size_t)bh * SEQ + tid * 8); const f32x4 v0 = src[0], v1 = src[1];
        const double tot = (((double)v0[0] + (double)v0[1]) + ((double)v0[2] + (double)v0[3])) + (((double)v1[0] + (double)v1[1]) + ((double)v1[2] + (double)v1[3]));
        double inc = tot;
#pragma unroll
        for (int o = 1; o < 64; o <<= 1) { const double t = __shfl_up(inc, o); if (lane >= o) inc += t; }
        if (lane == 63) wtot[wid] = inc;
        __syncthreads();
        double base = 0.0;
#pragma unroll
        for (int w = 0; w < 8; ++w) base += (w < wid) ? wtot[w] : 0.0;
        double run = base + inc - tot; constexpr double NRS = -11.313708498984761;
        f32x4 o0, o1;
        run += (double)v0[0]; o0[0] = (float)(run * NRS); run += (double)v0[1]; o0[1] = (float)(run * NRS); run += (double)v0[2]; o0[2] = (float)(run * NRS); run += (double)v0[3]; o0[3] = (float)(run * NRS);
        run += (double)v1[0]; o1[0] = (float)(run * NRS); run += (double)v1[1]; o1[1] = (float)(run * NRS); run += (double)v1[2]; o1[2] = (float)(run * NRS); run += (double)v1[3]; o1[3] = (float)(run * NRS);
        f32x4* dst = (f32x4*)(C + (size_t)bh * SEQ + tid * 8); dst[0] = o0; dst[1] = o1;
        __syncthreads();
    }
}

#define XSWZ(row, colB) ((row) * 256 + ((colB) ^ (((row) & 7) << 4)))
__device__ __forceinline__ int crow16(int r, int hi) { return (r & 3) + 8 * (r >> 2) + 4 * hi; }
__device__ __forceinline__ void lru_phase(const Params& P, unsigned char* lds_g, const bool dry) {
    int tid_l = threadIdx.x; asm volatile("" : "+v"(tid_l));
    const int tid = tid_l, lane = tid & 63, wid = __builtin_amdgcn_readfirstlane(tid >> 6), r32 = lane & 31, hi = lane >> 5;
    LAS unsigned char* lds = (LAS unsigned char*)lds_g;
    LAS unsigned char* XC = lds;
    LAS float* AS = (LAS float*)(lds + 65536);
    LAS float* US = (LAS float*)(lds + 98304);
    LAS float* SEG = (LAS float*)(lds + 131072); LAS float* CW = SEG + 2048; LAS unsigned char* WRS = lds + 141824; LAS unsigned char* WIS = lds + 150016;
    const bf16u* XL = (const bf16u*)(P.ws + WS_XL); bf16u* YL = (bf16u*)(P.ws + WS_YL); float* psl = (float*)(P.ws + WS_PSL);
    const bf16u* WrT = (const bf16u*)(P.ws + WS_WRT); const bf16u* WiT = (const bf16u*)(P.ws + WS_WIT);
    const int cgp = tid & 15, run = tid >> 4;
    const int ch = tid & 31, seg = tid >> 5;
    const int otok = tid >> 1, ohalf = tid & 1;
    for (int item = blockIdx.x; item < 256; item += gridDim.x) {
        const int jq = (item >> 3) & 3, grp = (item & 7) | ((item >> 5) << 3), b = grp >> 3, n = grp & 7;
        __syncthreads();
        for (int i = tid; i < 640; i += 512) CW[i] = i < 512 ? P.in[6][(i >> 7) * 1024 + n * 128 + (i & 127)] : P.in[7][n * 128 + (i - 512)];
        { const int wrow = tid >> 4, wch = tid & 15; const size_t o = (size_t)(n * 128 + jq * 32 + wrow) * 128 + wch * 8;
          *(LAS v4u*)(WRS + XSWZ(wrow, wch * 16)) = *(const v4u*)(WrT + o); *(LAS v4u*)(WIS + XSWZ(wrow, wch * 16)) = *(const v4u*)(WiT + o); }
        const int co = n * 128 + jq * 32 + ch;
        constexpr float L2E = 1.4426950408889634f;
        const float sp8 = 8.0f * log1pf(__expf(-P.in[12][co])), cbr = -P.in[9][co] * L2E, cbi = -P.in[11][co] * L2E, k1 = -sp8 * L2E, k2 = -2.0f * sp8;
        float carry = 0.f;
        const char* xlb = (const char*)(XL + (size_t)(b * SEQ) * DM + n * 128);
        char* ylb = (char*)(YL + (size_t)(b * SEQ) * DM + n * 128 + jq * 32);
        const unsigned xoff = (unsigned)((run * 8) * DM + cgp * 8) * 2u, yoff = (unsigned)(otok * DM + ohalf * 16) * 2u;
        v4u rows[11];
#pragma unroll
        for (int i = 0; i < 11; ++i) { const int s = run * 8 - 3 + i; const unsigned o = (unsigned)((s < 0 ? 0 : s) * DM + cgp * 8) * 2u; v4u v = *(const v4u*)(xlb + o); if (s < 0) v = (v4u){0u, 0u, 0u, 0u}; rows[i] = v; }
        __syncthreads();
#pragma unroll 1
        for (int chunk = 0; chunk < 16; ++chunk) {
            const int t0 = chunk * 256;
            LAS float* SEGA = SEG + (chunk & 1) * 1024; LAS float* SEGB = SEGA + 512;
            int tz = tid; asm volatile("" : "+v"(tz));
            const int lane = tz & 63, r32 = lane & 31, hi = lane >> 5, cgp = tz & 15, run = tz >> 4, ch = tz & 31, seg = tz >> 5, otok = tz >> 1, ohalf = tz & 1;
            const unsigned xoff = (unsigned)((run * 8) * DM + cgp * 8) * 2u, yoff = (unsigned)(otok * DM + ohalf * 16) * 2u;
#ifdef NO_PREF
            if (chunk > 0) {
#pragma unroll
                for (int i = 0; i < 11; ++i) rows[i] = *(const v4u*)(xlb + (xoff + (unsigned)((t0 + i - 3) * DM * 2)));
            }
#endif
            {
              h16x8 w8[4], bb8; asm volatile("" ::: "memory");
#pragma unroll
              for (int j = 0; j < 4; ++j) { const f32x4 a = *(const LAS f32x4*)(CW + j * 128 + cgp * 8), c = *(const LAS f32x4*)(CW + j * 128 + cgp * 8 + 4);
                  w8[j] = (h16x8){(_Float16)a[0], (_Float16)a[1], (_Float16)a[2], (_Float16)a[3], (_Float16)c[0], (_Float16)c[1], (_Float16)c[2], (_Float16)c[3]}; }
              { const f32x4 a = *(const LAS f32x4*)(CW + 512 + cgp * 8), c = *(const LAS f32x4*)(CW + 512 + cgp * 8 + 4);
                  bb8 = (h16x8){(_Float16)a[0], (_Float16)a[1], (_Float16)a[2], (_Float16)a[3], (_Float16)c[0], (_Float16)c[1], (_Float16)c[2], (_Float16)c[3]}; }
#pragma unroll
              for (int hf = 0; hf < 2; ++hf) { h16x8 y8[4];
#pragma unroll
                  for (int tk = 0; tk < 4; ++tk) y8[tk] = bb8;
#pragma unroll
                  for (int i = 0; i < 7; ++i) { const h16x8 x8 = __builtin_bit_cast(h16x8, rows[hf * 4 + i]);
#pragma unroll
                      for (int tk = 0; tk < 4; ++tk) { const int j = i - tk; if (j >= 0 && j < 4) y8[tk] = w8[j] * x8 + y8[tk]; } }
#pragma unroll
                  for (int tk = 0; tk < 4; ++tk) *(LAS v4u*)(XC + XSWZ(run * 8 + hf * 4 + tk, cgp * 16)) = __builtin_bit_cast(v4u, y8[tk]); } }
#ifndef NO_PREF
            if (chunk + 1 < 16) {
#pragma unroll
                for (int i = 0; i < 11; ++i) rows[i] = *(const v4u*)(xlb + (xoff + (unsigned)((t0 + 256 + i - 3) * DM * 2)));
            }
#endif
            LDS_WAIT();
            f32x16 R = {}, I = {};
#pragma unroll
            for (int kk = 0; kk < 8; ++kk) { const h16x8 a = *(const LAS h16x8*)(XC + XSWZ(wid * 32 + r32, (kk * 16 + hi * 8) * 2));
                const h16x8 wr_ = *(const LAS h16x8*)(WRS + XSWZ(r32, (kk * 16 + hi * 8) * 2)), wi_ = *(const LAS h16x8*)(WIS + XSWZ(r32, (kk * 16 + hi * 8) * 2));
                R = __builtin_amdgcn_mfma_f32_32x32x16_f16(a, wr_, R, 0, 0, 0); I = __builtin_amdgcn_mfma_f32_32x32x16_f16(a, wi_, I, 0, 0, 0); }
#pragma unroll
            for (int r = 0; r < 16; ++r) { const int tok = wid * 32 + crow16(r, hi); AS[tok * 32 + r32] = R[r]; US[tok * 32 + r32] = I[r]; }
            LDS_WAIT();
            const unsigned yo = yoff + (unsigned)(t0 * DM * 2);
            const v4u g0 = *(const v4u*)(ylb + yo), g1 = *(const v4u*)(ylb + yo + 16);
            { typedef float f32x2 __attribute__((ext_vector_type(2)));
              const int colB = (jq * 32 + ch) * 2; float A = 1.f, h = 0.f;
              const f32x2 one2 = (f32x2){1.0f, 1.0f};
#pragma unroll 2
              for (int i = 0; i < 16; i += 2) { const int tok = seg * 16 + i;
                const f32x2 rr = (f32x2){AS[tok * 32 + ch], AS[(tok + 1) * 32 + ch]}, ii = (f32x2){US[tok * 32 + ch], US[(tok + 1) * 32 + ch]};
                const unsigned short xb0 = *(const LAS unsigned short*)(XC + XSWZ(tok, colB & ~15) + (colB & 15)), xb1 = *(const LAS unsigned short*)(XC + XSWZ(tok + 1, colB & ~15) + (colB & 15));
                const f32x2 xcv = (f32x2){(float)__builtin_bit_cast(_Float16, xb0), (float)__builtin_bit_cast(_Float16, xb1)};
                f32x2 t1 = rr * (-L2E) + cbr, t2 = ii * (-L2E) + cbi;
                t1.x = fminf(t1.x, 60.f); t1.y = fminf(t1.y, 60.f); t2.x = fminf(t2.x, 60.f); t2.y = fminf(t2.y, 60.f);
                const f32x2 e1 = (f32x2){__builtin_amdgcn_exp2f(t1.x), __builtin_amdgcn_exp2f(t1.y)}, e2 = (f32x2){__builtin_amdgcn_exp2f(t2.x), __builtin_amdgcn_exp2f(t2.y)};
                const f32x2 d1 = e1 + one2, d2 = e2 + one2, dd = d1 * d2;
                const f32x2 rinv = (f32x2){__builtin_amdgcn_rcpf(dd.x), __builtin_amdgcn_rcpf(dd.y)}, rg = rinv * d2, ig = rinv * d1;
                const f32x2 la2 = rg * k1, x = rg * k2;
                const f32x2 a = (f32x2){__builtin_amdgcn_exp2f(la2.x), __builtin_amdgcn_exp2f(la2.y)};
                f32x2 pz = x * (1.0f / 720.0f) + (1.0f / 120.0f); pz = pz * x + (1.0f / 24.0f); pz = pz * x + (1.0f / 6.0f); pz = pz * x + 0.5f; pz = pz * x + one2;
                const f32x2 ms = -(x * pz), mb = one2 - a * a;
                const f32x2 m2 = (f32x2){x.x > -0.25f ? ms.x : mb.x, x.y > -0.25f ? ms.y : mb.y};
                const f32x2 u = (f32x2){__builtin_amdgcn_sqrtf(m2.x), __builtin_amdgcn_sqrtf(m2.y)} * ig * xcv;
                AS[tok * 32 + ch] = a.x; US[tok * 32 + ch] = u.x; AS[(tok + 1) * 32 + ch] = a.y; US[(tok + 1) * 32 + ch] = u.y;
                h = a.x * h + u.x; h = a.y * h + u.y; A *= a.x * a.y; }
              SEGA[seg * 32 + ch] = A; SEGB[seg * 32 + ch] = h; }
            asm volatile("s_waitcnt lgkmcnt(0)\n\ts_barrier" ::: "memory");
            { float sa[16], sb[16];
#pragma unroll
              for (int s = 0; s < 16; ++s) { sa[s] = SEGA[s * 32 + ch]; sb[s] = SEGB[s * 32 + ch]; }
              float c = carry, cin = carry;
#pragma unroll
              for (int s = 0; s < 16; ++s) { cin = (s == seg) ? c : cin; c = sa[s] * c + sb[s]; }
              carry = c;
              float h = cin;
#pragma unroll 4
              for (int i = 0; i < 16; ++i) { const int idx = (seg * 16 + i) * 32 + ch; h = AS[idx] * h + US[idx]; US[idx] = h; } }
            LDS_WAIT();
            { const LAS f32x4* hp = (const LAS f32x4*)(US + otok * 32 + ohalf * 16); const f32x4 h0 = hp[0], h1 = hp[1], h2 = hp[2], h3 = hp[3];
              float s2 = (h0[0] * h0[0] + h0[1] * h0[1]) + (h0[2] * h0[2] + h0[3] * h0[3]) + (h1[0] * h1[0] + h1[1] * h1[1]) + (h1[2] * h1[2] + h1[3] * h1[3])
                       + (h2[0] * h2[0] + h2[1] * h2[1]) + (h2[2] * h2[2] + h2[3] * h2[3]) + (h3[0] * h3[0] + h3[1] * h3[1]) + (h3[2] * h3[2] + h3[3] * h3[3]);
              v4u o0, o1;
              o0.x = pk2(h0[0] * pg8::bf_lo(g0.x), h0[1] * pg8::bf_hi(g0.x)); o0.y = pk2(h0[2] * pg8::bf_lo(g0.y), h0[3] * pg8::bf_hi(g0.y));
              o0.z = pk2(h1[0] * pg8::bf_lo(g0.z), h1[1] * pg8::bf_hi(g0.z)); o0.w = pk2(h1[2] * pg8::bf_lo(g0.w), h1[3] * pg8::bf_hi(g0.w));
              o1.x = pk2(h2[0] * pg8::bf_lo(g1.x), h2[1] * pg8::bf_hi(g1.x)); o1.y = pk2(h2[2] * pg8::bf_lo(g1.y), h2[3] * pg8::bf_hi(g1.y));
              o1.z = pk2(h3[0] * pg8::bf_lo(g1.z), h3[1] * pg8::bf_hi(g1.z)); o1.w = pk2(h3[2] * pg8::bf_lo(g1.w), h3[3] * pg8::bf_hi(g1.w));
              s2 += __shfl_xor(s2, 1);
              if (!dry) { *(v4u*)(ylb + yo) = o0; *(v4u*)(ylb + yo + 16) = o1;
                if (ohalf == 0) psl[(size_t)(n * 4 + jq) * M + b * SEQ + t0 + otok] = s2; } }
        }
    }
    __syncthreads();
}

__device__ __forceinline__ void attn_phase(const Params& P, unsigned char* lds_g, const int dry) {
    using namespace att;
    typedef __hip_bfloat16 T;
    char* lds = (char*)lds_g;
    const T* Qb = (const T*)(P.ws + WS_Q); const T* Kb = (const T*)(P.ws + WS_K); const T* Vb = (const T*)(P.ws + WS_V); T* YA = (T*)(P.ws + WS_YA);
    const float* Cb = (const float*)(P.ws + WS_C); float* psa = (float*)(P.ws + WS_PSA);
    constexpr int order = ORDER_PAIRED | ORDER_XCD, nqb = SQ / QB, nramp = nqb, nx = (nramp + 1) / 2, total = nx * B * H;
    const int stride = gridDim.x;
    int L = blockIdx.x; if (L >= total) return;
#define MKREF(it_, pass_) ({ const int qb_ = (pass_) ? (it_).qb1 : (it_).qb0; const int b_ = (it_).bh >> 3, h_ = (it_).bh & 7; BlockRef<T, T> r_; \
        r_.Q = Qb + ((size_t)(it_).bh * SQ + (size_t)qb_ * QB) * D; r_.K = Kb + (size_t)(dry == 2 ? 0 : (it_).bh) * SKV * D; r_.V = Vb + (size_t)(dry == 2 ? 0 : (it_).bh) * SKV * D; \
        r_.O = YA + ((size_t)(b_ * SQ + qb_ * QB)) * OP + h_ * D; r_.C = Cb + (size_t)(it_).bh * SQ; r_.SSQ = psa + (size_t)h_ * M + b_ * SQ + qb_ * QB; r_.P0 = qb_ * QB; r_.dry = dry; r_; })
    SwaItem it = swa_decode(L, B, H, HKV, nqb, nx, nramp, order); int pass = 0;
    BlockRef<T, T> cur = MKREF(it, 0);
    Seam<T> S;
    causal_swa_prime<T, T>(cur, WINDOW, lds, S);
    for (;;) {
        const bool more_pass = pass == 0 && it.qb1 != it.qb0, more_item = L + stride < total, last = !more_pass && !more_item;
        SwaItem itn = it; int passn = pass + 1, Ln = L;
        if (!more_pass) { passn = 0; Ln = more_item ? L + stride : L; itn = swa_decode(Ln, B, H, HKV, nqb, nx, nramp, order); }
        const BlockRef<T, T> nxt = last ? cur : MKREF(itn, passn);
        causal_swa_block<T, T>(cur, nxt, SKV, WINDOW, lds, S);
        if (last) break;
        cur = nxt; it = itn; pass = passn; L = Ln;
    }
#undef MKREF
}

__global__ void __launch_bounds__(512, 2) fwd_mega(Params P) {
    extern __shared__ __attribute__((aligned(16))) unsigned char lds[];
    const int lo = P.lo, hi = P.hi;
    unsigned char* ws = P.ws;
    volatile LAS unsigned* xst = (volatile LAS unsigned*)((LAS unsigned char*)lds + (LDS_BYTES - 64));
    if (threadIdx.x < 2) xst[threadIdx.x] = 0u;
    __syncthreads();
    XcdBarrier xbar; xbar.bar = (unsigned*)(ws + WS_BAR); xbar.x = 0; xbar.st = xst;
    if (hi - lo > 1) xbar = xcd_barrier_post((unsigned*)(ws + WS_BAR), xst);
    if (lo < 0) cg::this_grid().sync();
    pg8::bf16_t* XN = (pg8::bf16_t*)(ws + WS_XN);
#ifndef PH_MASK
#define PH_MASK 31
#endif
#define IN(k) (((PH_MASK >> (k)) & 1) && lo <= (k) && (k) < hi)
#define SEAM(k) do { if (IN(k) && IN((k) + 1)) { xcd_barrier(xbar); } } while (0)
#ifndef PROBE_PHASE
#define PROBE_PHASE -1
#endif
    const float* psa = (const float*)(ws + WS_PSA); const float* psl = (const float*)(ws + WS_PSL); float* psm = (float*)(ws + WS_PSM); float* pse = (float*)(ws + WS_PSE); float* dummyf = (float*)(ws + WS_V);
    if (IN(0)) {
#pragma unroll 1
        for (int rp = (PROBE_PHASE == 0 ? 0 : 1); rp < 2; ++rp) { p0_phase(P, lds); __syncthreads(); } }
    SEAM(0);
    if (IN(1)) {
        cumsum_phase(P, lds);
        static_assert(WS_K - WS_Q == 64 * MiB && WS_V - WS_K == 64 * MiB && WS_YA - WS_V == 64 * MiB && WS_XL - WS_YA == 64 * MiB && WS_YL - WS_XL == 64 * MiB, "region map");
#pragma unroll 1
        for (int rp = (PROBE_PHASE == 1 ? 0 : 1); rp < 2; ++rp) {
        pg8::Gemm g{XN, XN, (const pg8::bf16_t*)(ws + WS_W1), M, N1, DM, DM, DM / 64}; pg8::StaticOrder S; S.init(M, N1, gridDim.x, (int)blockIdx.x);
        pg8::EpiIn E{(pg8::bf16_t*)(ws + WS_Q)};
        pg8::gemm_phase<pg8::EpiIn, pg8::StaticOrder, true, true>((PG8_LAS unsigned char*)lds, g, S, E); }
    }
    SEAM(1);
    if (IN(2)) {
#pragma unroll 1
        for (int rp = (PROBE_PHASE == 2 ? 0 : 1); rp < 2; ++rp) lru_phase(P, lds, rp == 0);
#pragma unroll 1
        for (int rp = (PROBE_PHASE == 3 ? 0 : 1); rp < 2; ++rp) attn_phase(P, lds, rp == 0 ? 1 : 0);
    }
    SEAM(2);
    if (IN(3)) {
#pragma unroll 1
        for (int rp = (PROBE_PHASE == 4 ? 0 : 1); rp < 2; ++rp) {
        { pg8::Gemm g{(const pg8::bf16_t*)(ws + WS_PB), (const pg8::bf16_t*)(ws + WS_PB), (const pg8::bf16_t*)(ws + WS_WPLE), M, DM, DPLE, DPLE, DPLE / 64}; pg8::StaticOrder S; S.init(M, DM, gridDim.x, (int)blockIdx.x);
          pg8::EpiPle E{(pg8::bf16_t*)(ws + (rp ? WS_EP : WS_XL)), rp ? pse : dummyf};
          pg8::gemm_phase<pg8::EpiPle, pg8::StaticOrder, true, true>((PG8_LAS unsigned char*)lds, g, S, E); }
        { pg8::Gemm g{(const pg8::bf16_t*)(ws + WS_YA), (const pg8::bf16_t*)(ws + WS_YL), (const pg8::bf16_t*)(ws + WS_WOUT), M, DM, 2 * DM, DM, DM / 64}; pg8::StaticOrder S; S.init(M, DM, gridDim.x, (int)blockIdx.x);
          PG8_LAS float* scm = (PG8_LAS float*)((PG8_LAS unsigned char*)lds + 131072); PG8_LAS float* sce = scm + 2048;
          { pg8::Unit uu; for (int i = 0; i < 8 && S.next(i, uu); ++i) if (threadIdx.x < 256) { const int r = uu.pm * 256 + threadIdx.x; float sa = 0.f, sl = 0.f;
#pragma unroll
                for (int k = 0; k < 8; ++k) sa += psa[(size_t)k * M + r];
#pragma unroll
                for (int k = 0; k < 32; ++k) sl += psl[(size_t)k * M + r];
                const float ra = pg8::rstd_of(sa), rl = pg8::rstd_of(sl);
                scm[i * 256 + threadIdx.x] = ra / rl; sce[i * 256 + threadIdx.x] = rl; } }
          __syncthreads();
          pg8::EpiOut E{(pg8::bf16_t*)(ws + (rp ? WS_MIX : WS_XL)), scm, sce, rp ? psm : dummyf};
          pg8::gemm_phase<pg8::EpiOut, pg8::StaticOrder, true, true>((PG8_LAS unsigned char*)lds, g, S, E); } }
    }
    SEAM(3);
    if (IN(4)) {
#pragma unroll 1
        for (int rp = (PROBE_PHASE == 5 ? 0 : 1); rp < 2; ++rp) {
        pg8::Gemm g{XN, (const pg8::bf16_t*)(ws + WS_MIX), (const pg8::bf16_t*)(ws + WS_WG), M, DM, 2 * DM, DM, DM / 64}; pg8::StaticOrder S; S.init(M, DM, gridDim.x, (int)blockIdx.x);
        PG8_LAS float* scm = (PG8_LAS float*)((PG8_LAS unsigned char*)lds + 131072); PG8_LAS float* sce = scm + 2048; PG8_LAS float* scr = sce + 2048;
        { pg8::Unit uu; const float* rsxp = (const float*)(ws + WS_RSX);
          for (int i = 0; i < 8 && S.next(i, uu); ++i) if (threadIdx.x < 256) { const int r = uu.pm * 256 + threadIdx.x; float sm = 0.f, se = 0.f;
#pragma unroll
              for (int k = 0; k < 16; ++k) { sm += psm[(size_t)k * M + r]; se += pse[(size_t)k * M + r]; }
              const float rm = pg8::rstd_of(sm);
              scm[i * 256 + threadIdx.x] = rsxp[r] / rm; sce[i * 256 + threadIdx.x] = rm; scr[i * 256 + threadIdx.x] = pg8::rstd_of(se); } }
        __syncthreads();
        pg8::EpiFin E{P.in[0], scm, sce, scr, P.in[19], P.in[5], P.in[17],
                      (const pg8::bf16_t*)(ws + WS_MIX), (const pg8::bf16_t*)(ws + WS_EP), rp ? P.out : (float*)(ws + WS_V)};
        pg8::gemm_phase<pg8::EpiFin, pg8::StaticOrder, true, true>((PG8_LAS unsigned char*)lds, g, S, E); }
    }
#undef IN
#undef SEAM
}

#if PROBE_PHASE >= 10
__global__ void __launch_bounds__(512, 2) probe_kernel(Params P) {
    extern __shared__ __attribute__((aligned(16))) unsigned char lds[];
#if PROBE_PHASE == 10
    p0_phase(P, lds);
#elif PROBE_PHASE == 17
    attn_phase(P, lds, 2);
#elif PROBE_PHASE == 18
    attn_phase(P, lds, 1);
#elif PROBE_PHASE == 13
    attn_phase(P, lds, 0);
#elif PROBE_PHASE == 14
    { unsigned char* ws = P.ws; pg8::Gemm g{(const pg8::bf16_t*)(ws + WS_PB), (const pg8::bf16_t*)(ws + WS_PB), (const pg8::bf16_t*)(ws + WS_WPLE), M, DM, DPLE, DPLE, DPLE / 64}; pg8::StaticOrder S; S.init(M, DM, gridDim.x, (int)blockIdx.x);
      pg8::EpiPle E{(pg8::bf16_t*)(ws + WS_V), (float*)(ws + WS_XL)};
      pg8::gemm_phase<pg8::EpiPle, pg8::StaticOrder, true, true>((PG8_LAS unsigned char*)lds, g, S, E); }
#elif PROBE_PHASE == 15
    { unsigned char* ws = P.ws; const float* psa = (const float*)(ws + WS_PSA); const float* psl = (const float*)(ws + WS_PSL);
      pg8::Gemm g{(const pg8::bf16_t*)(ws + WS_YA), (const pg8::bf16_t*)(ws + WS_YL), (const pg8::bf16_t*)(ws + WS_WOUT), M, DM, 2 * DM, DM, DM / 64}; pg8::StaticOrder S; S.init(M, DM, gridDim.x, (int)blockIdx.x);
      PG8_LAS float* scm = (PG8_LAS float*)((PG8_LAS unsigned char*)lds + 131072); PG8_LAS float* sce = scm + 2048;
      { pg8::Unit uu; for (int i = 0; i < 8 && S.next(i, uu); ++i) if (threadIdx.x < 256) { const int r = uu.pm * 256 + threadIdx.x; float sa = 0.f, sl = 0.f; for (int k = 0; k < 8; ++k) sa += psa[(size_t)k * M + r]; for (int k = 0; k < 32; ++k) sl += psl[(size_t)k * M + r];
            const float ra = pg8::rstd_of(sa), rl = pg8::rstd_of(sl); scm[i * 256 + threadIdx.x] = ra / rl; sce[i * 256 + threadIdx.x] = rl; } }
      __syncthreads();
      pg8::EpiOut E{(pg8::bf16_t*)(ws + WS_XL), scm, sce, (float*)(ws + WS_V)};
      pg8::gemm_phase<pg8::EpiOut, pg8::StaticOrder, true, true>((PG8_LAS unsigned char*)lds, g, S, E); }
#endif
}
#endif
extern "C" void kernel_launch(void* const* d_in, const int* in_sizes, int n_in, void* d_out, int out_size, void* d_ws, size_t ws_size, hipStream_t stream) {
    static int grid = 0;
    if (grid == 0) {
        if (n_in != 20 || in_sizes[0] != M * DM || out_size != M * DM || ws_size < WS_END) { fprintf(stderr, "kernel_launch: shape mismatch (n_in %d, in0 %d, out %d, ws %zu)\n", n_in, n_in > 0 ? in_sizes[0] : -1, out_size, ws_size); grid = -1; return; }
        int dev = 0, cus = 0, per_cu = 0;
        (void)hipGetDevice(&dev); (void)hipDeviceGetAttribute(&cus, hipDeviceAttributeMultiprocessorCount, dev);
        if (hipFuncSetAttribute((const void*)fwd_mega, hipFuncAttributeMaxDynamicSharedMemorySize, LDS_BYTES) != hipSuccess) { fprintf(stderr, "kernel_launch: hipFuncSetAttribute failed\n"); grid = -1; return; }
        if (hipOccupancyMaxActiveBlocksPerMultiprocessor(&per_cu, (const void*)fwd_mega, 512, LDS_BYTES) != hipSuccess || per_cu < 1) { fprintf(stderr, "kernel_launch: occupancy query says %d\n", per_cu); per_cu = 1; }
        (void)hipGetLastError();
        grid = cus * per_cu; if (grid <= 0) grid = 256;
        if (grid < 64) { fprintf(stderr, "kernel_launch: grid %d < 64 workgroups: the per-workgroup row-scale tables hold at most 8 units\n", grid); grid = -1; return; }
    }
    if (grid < 0) return;
    Params p{};
    for (int i = 0; i < 20; ++i) p.in[i] = (const float*)d_in[i];
    p.out = (float*)d_out; p.ws = (unsigned char*)d_ws;
#if N_LAUNCHES == 1
    p.lo = 0; p.hi = 5;
    if (hipMemsetAsync((char*)d_ws + WS_BAR, 0, BAR_BYTES, stream) != hipSuccess) { fprintf(stderr, "kernel_launch: memset failed\n"); return; }
    void* args[] = {&p};
    hipError_t e = hipLaunchCooperativeKernel((const void*)fwd_mega, dim3(grid), dim3(512), args, LDS_BYTES, stream);
    if (e != hipSuccess) fprintf(stderr, "cooperative launch failed: %s (grid %d)\n", hipGetErrorString(e), grid);
#if PROBE_PHASE >= 10
    (void)hipFuncSetAttribute((const void*)probe_kernel, hipFuncAttributeMaxDynamicSharedMemorySize, LDS_BYTES);
    hipLaunchKernelGGL(probe_kernel, dim3(grid), dim3(512), LDS_BYTES, stream, p);
#endif
#else
    for (int ph = 0; ph < 5; ++ph) { p.lo = ph; p.hi = ph + 1; hipLaunchKernelGGL(fwd_mega, dim3(grid), dim3(512), LDS_BYTES, stream, p); }
#endif
}
```
